# Optimizing an MI355X kernel written in HIP

```python
import jax, jax.numpy as jnp
from jax import lax
import numpy as np

D_MODEL = 1024
BATCH = 2
SEQ = 8192
DEPTH = 2
DEC_BATCH = 16
DEC_SEQ = 16
PAST_LEN = 1024

CHUNK = 64
QBLOCK = 128
H_SB = 8
D_SB = 64
W_SB = H_SB * D_SB
H_GLA = 4
DK_GLA = 64
DV_GLA = 128
WK_GLA = H_GLA * DK_GLA
WV_GLA = H_GLA * DV_GLA
GATE_RANK = 16
GATE_TAU = 16.0
D_FF = 4 * D_MODEL
N_MOD = 6
EPS = 1e-6
IN_SIZES = (W_SB, W_SB, W_SB, WK_GLA, WK_GLA, WV_GLA, GATE_RANK, WV_GLA)
N_IN = W_SB * 3 + WK_GLA * 2 + WV_GLA * 2 + GATE_RANK

kernel_name = "hymba_stickbreaking_gla_adaln_stream"


def _rmsnorm(x, g):
    x32 = x.astype(jnp.float32)
    y = x32 * lax.rsqrt(jnp.mean(x32 * x32, axis=-1, keepdims=True) + EPS)
    return (y * g.astype(jnp.float32)).astype(x.dtype)


def _split_points():
    pts, acc = [], 0
    for s in IN_SIZES[:-1]:
        acc += s
        pts.append(acc)
    return pts


def _sb_block(qb, qpos, k, v, kpos):
    z = jnp.einsum('bqhd,bkhd->bhqk', qb, k).astype(jnp.float32) * (D_SB ** -0.5)
    mask = kpos[None, :] < qpos[:, None]
    l_neg = jnp.where(mask, jax.nn.log_sigmoid(-z), 0.0)
    between = lax.cumsum(l_neg, axis=3, reverse=True) - l_neg
    w = jnp.where(mask, jnp.exp(jax.nn.log_sigmoid(z) + between), 0.0)
    return jnp.einsum('bhqk,bkhd->bqhd', w.astype(v.dtype), v)


def _stick_breaking(q, k, v, q_offset):
    B, T, H, d = q.shape
    kpos = jnp.arange(k.shape[1])
    qb = min(QBLOCK, T)
    nb = T // qb
    qs = q.reshape(B, nb, qb, H, d).swapaxes(0, 1)
    qpos = (q_offset + jnp.arange(T)).reshape(nb, qb)
    out = lax.map(lambda a: _sb_block(a[0], a[1], k, v, kpos), (qs, qpos))
    return out.swapaxes(0, 1).reshape(B, T, H, d)


def _gla_chunk(S, inp):
    q, k, v, g = inp
    L = q.shape[1]
    b = jnp.cumsum(g, axis=1)
    causal = jnp.tril(jnp.ones((L, L), dtype=bool))[None, :, :, None, None]
    diff = b[:, :, None] - b[:, None, :]
    decay = jnp.exp(jnp.where(causal, diff, -jnp.inf))
    att = jnp.einsum('bthd,bshd,btshd->bhts', q, k, decay)
    o = jnp.einsum('bhts,bshv->bthv', att, v) + jnp.einsum('bthd,bhdv->bthv', q * jnp.exp(b), S)
    b_last = b[:, -1]
    S_new = jnp.exp(b_last)[..., None] * S + jnp.einsum(
        'bshd,bshv->bhdv', k * jnp.exp(b_last[:, None] - b), v)
    return S_new, o


def _gla(q, k, v, g, S0):
    B, T = q.shape[:2]
    L = min(CHUNK, T)
    nc = T // L

    def to_chunks(a):
        return a.reshape(B, nc, L, *a.shape[2:]).swapaxes(0, 1)

    S, o = lax.scan(_gla_chunk, S0, (to_chunks(q), to_chunks(k), to_chunks(v), to_chunks(g)))
    return o.swapaxes(0, 1).reshape(B, T, H_GLA, DV_GLA), S


def _mixer(h, p, l, k_past, v_past, S0):
    B, T, _ = h.shape
    proj = h @ p['w_in'][l]
    qa, ka, va, qg, kg, vg, gr, og = jnp.split(proj, _split_points(), axis=-1)
    qa = _rmsnorm(qa.reshape(B, T, H_SB, D_SB), p['q_norm'][l])
    ka = _rmsnorm(ka.reshape(B, T, H_SB, D_SB), p['k_norm'][l])
    va = va.reshape(B, T, H_SB, D_SB)
    if k_past is None:
        k_all, v_all, q_offset = ka, va, 0
    else:
        k_all = jnp.concatenate([k_past.astype(ka.dtype), ka], axis=1)
        v_all = jnp.concatenate([v_past.astype(va.dtype), va], axis=1)
        q_offset = k_past.shape[1]
    a_out = _stick_breaking(qa, k_all, v_all, q_offset).reshape(B, T, W_SB)
    f32 = jnp.float32
    qg = qg.reshape(B, T, H_GLA, DK_GLA).astype(f32) * (DK_GLA ** -0.5)
    kg = kg.reshape(B, T, H_GLA, DK_GLA).astype(f32)
    vg = vg.reshape(B, T, H_GLA, DV_GLA).astype(f32)
    logf = jax.nn.log_sigmoid((gr @ p['w_gate'][l] + p['b_gate'][l]).astype(f32)) / GATE_TAU
    o, S = _gla(qg, kg, vg, logf.reshape(B, T, H_GLA, DK_GLA), S0)
    o = _rmsnorm(o, p['gla_norm'][l]).astype(h.dtype) * jax.nn.silu(og.reshape(B, T, H_GLA, DV_GLA))
    merged = jnp.concatenate([a_out, o.reshape(B, T, WV_GLA)], axis=-1)
    return merged @ p['w_out'][l], ka, va, S


def _layer(x, c, p, l, k_past, v_past, S0):
    mod = jax.nn.silu(c) @ p['w_ada'][l] + p['b_ada'][l]
    sh1, sc1, g1, sh2, sc2, g2 = jnp.split(mod[:, None, :], N_MOD, axis=-1)
    h = _rmsnorm(x, p['norm_mix'][l]) * (1.0 + sc1) + sh1
    m, k_new, v_new, S = _mixer(h, p, l, k_past, v_past, S0)
    x = x + g1 * m
    h = _rmsnorm(x, p['norm_mlp'][l]) * (1.0 + sc2) + sh2
    x = x + g2 * (jnp.square(jax.nn.relu(h @ p['w_up'][l])) @ p['w_down'][l])
    return x, k_new, v_new, S


def setup_inputs(seed: int = 0) -> dict:
    key = jax.random.key(seed)
    ks = jax.random.split(key, 20)
    n = jax.random.normal
    f = jnp.float32
    return {
        'x_prompt': n(ks[0], (BATCH, SEQ, D_MODEL), f),
        'x_sample': n(ks[1], (DEC_BATCH, DEC_SEQ, D_MODEL), f),
        'c_prompt': n(ks[2], (BATCH, D_MODEL), f),
        'c_sample': n(ks[3], (DEC_BATCH, D_MODEL), f),
        'cache_k': n(ks[4], (DEPTH, DEC_BATCH, PAST_LEN, H_SB, D_SB), f),
        'cache_v': n(ks[5], (DEPTH, DEC_BATCH, PAST_LEN, H_SB, D_SB), f),
        'state_gla': 0.3 * n(ks[6], (DEPTH, DEC_BATCH, H_GLA, DK_GLA, DV_GLA), f),
        'w_ada': 0.5 * D_MODEL ** -0.5 * n(ks[7], (DEPTH, D_MODEL, N_MOD * D_MODEL), f),
        'b_ada': 0.01 * n(ks[8], (DEPTH, N_MOD * D_MODEL), f),
        'norm_mix': 1.0 + 0.05 * n(ks[9], (DEPTH, D_MODEL), f),
        'norm_mlp': 1.0 + 0.05 * n(ks[10], (DEPTH, D_MODEL), f),
        'w_in': D_MODEL ** -0.5 * n(ks[11], (DEPTH, D_MODEL, N_IN), f),
        'q_norm': 1.0 + 0.05 * n(ks[12], (DEPTH, D_SB), f),
        'k_norm': 1.0 + 0.05 * n(ks[13], (DEPTH, D_SB), f),
        'w_gate': GATE_RANK ** -0.5 * n(ks[14], (DEPTH, GATE_RANK, WK_GLA), f),
        'b_gate': 0.01 * n(ks[15], (DEPTH, WK_GLA), f),
        'gla_norm': 1.0 + 0.05 * n(ks[16], (DEPTH, DV_GLA), f),
        'w_out': D_MODEL ** -0.5 * n(ks[17], (DEPTH, W_SB + WV_GLA, D_MODEL), f),
        'w_up': D_MODEL ** -0.5 * n(ks[18], (DEPTH, D_MODEL, D_FF), f),
        'w_down': D_FF ** -0.5 * n(ks[19], (DEPTH, D_FF, D_MODEL), f),
    }


def reference(x_prompt, x_sample, c_prompt, c_sample, cache_k, cache_v, state_gla,
              w_ada, b_ada, norm_mix, norm_mlp, w_in, q_norm, k_norm, w_gate, b_gate,
              gla_norm, w_out, w_up, w_down):
    p = {'w_ada': w_ada, 'b_ada': b_ada, 'norm_mix': norm_mix, 'norm_mlp': norm_mlp,
         'w_in': w_in, 'q_norm': q_norm, 'k_norm': k_norm, 'w_gate': w_gate, 'b_gate': b_gate,
         'gla_norm': gla_norm, 'w_out': w_out, 'w_up': w_up, 'w_down': w_down}
    xp, xs = x_prompt, x_sample
    kp_l, vp_l, sp_l, ks_l, vs_l, ss_l = [], [], [], [], [], []
    for l in range(DEPTH):
        S0 = jnp.zeros((xp.shape[0], H_GLA, DK_GLA, DV_GLA), jnp.float32)
        xp, kp, vp, sp = _layer(xp, c_prompt, p, l, None, None, S0)
        xs, kn, vn, sn = _layer(xs, c_sample, p, l, cache_k[l], cache_v[l],
                                state_gla[l].astype(jnp.float32))
        kp_l.append(kp); vp_l.append(vp); sp_l.append(sp.astype(xp.dtype))
        ks_l.append(kn); vs_l.append(vn); ss_l.append(sn.astype(xs.dtype))
    k_prompt = jnp.stack(kp_l)
    v_prompt = jnp.stack(vp_l)
    gla_state_prompt = jnp.stack(sp_l)
    k_sample_new = jnp.stack(ks_l)
    v_sample_new = jnp.stack(vs_l)
    gla_state_sample = jnp.stack(ss_l)
    return (xp, xs, k_prompt, v_prompt, gla_state_prompt, k_sample_new, v_sample_new, gla_state_sample)
```

```cpp
#include <hip/hip_runtime.h>
#include <hip/hip_cooperative_groups.h>
#include <cstdio>
#include <cstdint>
namespace cg = cooperative_groups;
namespace pg8 {
#define PG8_LAS __attribute__((address_space(3)))
typedef unsigned short bf16_t;
typedef short bf16x8 __attribute__((ext_vector_type(8)));
typedef float f32x4 __attribute__((ext_vector_type(4)));
typedef unsigned u32x4 __attribute__((ext_vector_type(4)));
constexpr int BM = 256, BK = 64, HALF = 128, HTB = HALF * BK * 2  , STAGE_BYTES = 8 * HTB, NXCD = 8, WGM = 8;

__host__ __device__ __forceinline__ int lds_byte(int r, int c) { const int st = (r >> 4) * 2 + (c >> 5), rr = r & 15, cc = c & 31, ob = rr * 64 + cc * 2; return st * 1024 + (ob ^ (((ob >> 9) & 1) << 5)); }
__host__ __device__ __forceinline__ void stage_rc(int b, int& R, int& C) { const int st = b / 1024, sb = b % 1024, swz = sb ^ (((sb >> 9) & 1) << 5); R = (st >> 1) * 16 + swz / 64; C = (st & 1) * 32 + (swz % 64) / 2; }
__host__ __device__ __forceinline__ int perm32(int rho) { const int n = rho >> 4, i = rho & 15; return 8 * (i >> 2) + 4 * n + (i & 3); }

struct Unit { int pm, pn; };
struct Gemm { const bf16_t* A; const bf16_t* Bt; int M, N, K; };

struct StaticOrder {
    int nM, nN, nwg, G, c;
    __host__ __device__ void init(int M, int N, int G_, int c_) { nM = M / BM; nN = N / BM; nwg = nM * nN; G = G_; c = c_; }
    __host__ __device__ bool next(int i, Unit& u) const {
        const long L = (long)i * G + c; if (L >= nwg) return false;
        int wgid = (int)L; { const int q = nwg / NXCD, r = nwg % NXCD, xcd = wgid % NXCD, off = wgid / NXCD; wgid = (xcd < r ? xcd * (q + 1) : r * (q + 1) + (xcd - r) * q) + off; }
        const int nig = WGM * nN, gid = wgid / nig, fm = gid * WGM, gsz = (nM - fm) < WGM ? (nM - fm) : WGM;
        u.pm = fm + ((wgid % nig) % gsz); u.pn = (wgid % nig) / gsz; return true;
    }
    __device__ __forceinline__ void a_ready(const Unit&) const {}
    __device__ __forceinline__ void done(const Unit&) const {}
};

__device__ __forceinline__ unsigned cvt_pk_bf16(float lo, float hi) { unsigned r; asm volatile("v_cvt_pk_bf16_f32 %0, %1, %2" : "=v"(r) : "v"(lo), "v"(hi)); return r; }
template <class Epi, class Sched, bool ALIGN_EPI = false, bool SP2 = false>
__device__ __forceinline__ void gemm_phase(PG8_LAS unsigned char* lds, const Gemm g, const Sched& S, const Epi& E) {
    int tid_ = threadIdx.x; asm volatile("" : "+v"(tid_));
    const int tid = tid_, wid = __builtin_amdgcn_readfirstlane(tid >> 6), lane = tid & 63, wr = wid >> 2, wc = wid & 3, fr = lane & 15, fq = lane >> 4;
    const int K = g.K, nt = K / BK;
    unsigned voffA[2], voffB[2];
#pragma unroll
    for (int i = 0; i < 2; ++i) { int R, C; stage_rc(tid * 16 + i * 8192, R, C); const int Rb = Epi::PERM ? ((R & ~31) + perm32(R & 31)) : R;
        voffA[i] = (unsigned)(R * K + C) * 2u; voffB[i] = (unsigned)(Rb * K + C) * 2u; }
    const size_t kstep = (size_t)(BK * 2);
    const size_t hstep = (size_t)HALF * K * 2;
    const size_t tstep = 2 * hstep;
    const unsigned ldsw = (unsigned)wid * 1024u;
    const int aoff = lds_byte(wr * 64 + fr, fq * 8), boff = lds_byte(wc * 32 + fr, fq * 8);
#define PG8_SA(b, h) (((b) * 2 + (h)) * HTB)
#define PG8_SB(b, h) ((4 + (b) * 2 + (h)) * HTB)
#define PG8_STAGE(bufoff, gbase, voff) do { _Pragma("unroll") for (int _i = 0; _i < 2; ++_i) \
        __builtin_amdgcn_global_load_lds((const unsigned*)((const char*)(gbase) + (voff)[_i]), (PG8_LAS unsigned*)(lds + (bufoff) + ldsw + _i * 8192), 16, 0, 0); } while (0)
#define PG8_LDA(dst, b, h) do { _Pragma("unroll") for (int m = 0; m < 4; ++m) _Pragma("unroll") for (int k = 0; k < 2; ++k) dst[m][k] = *(const PG8_LAS bf16x8*)(lds + PG8_SA(b, h) + aoff + m * 2048 + k * 1024); } while (0)
#define PG8_LDB(dst, b, h) do { _Pragma("unroll") for (int n = 0; n < 2; ++n) _Pragma("unroll") for (int k = 0; k < 2; ++k) dst[n][k] = *(const PG8_LAS bf16x8*)(lds + PG8_SB(b, h) + boff + n * 2048 + k * 1024); } while (0)
#define PG8_MMA(ai, bj, At, Bt) do { __builtin_amdgcn_s_setprio(1); _Pragma("unroll") for (int m = 0; m < 4; ++m) _Pragma("unroll") for (int n = 0; n < 2; ++n) _Pragma("unroll") for (int k = 0; k < 2; ++k) \
        acc[ai][bj][m][n] = __builtin_amdgcn_mfma_f32_16x16x32_bf16(Bt[n][k], At[m][k], acc[ai][bj][m][n], 0, 0, 0); __builtin_amdgcn_s_setprio(0); } while (0)
#define PG8_WAIT_V(n) asm volatile("s_waitcnt vmcnt(" #n ")" ::: "memory")
#define PG8_WAIT_L(n) asm volatile("s_waitcnt lgkmcnt(" #n ")" ::: "memory")
#define PG8_BAR __builtin_amdgcn_s_barrier()
#define PG8_SCHED __builtin_amdgcn_sched_barrier(0)
    Unit cur, nxt; int ui = 0;
    if (!S.next(0, cur)) return;
    f32x4 acc[2][2][4][2];
#pragma unroll
    for (int a = 0; a < 2; ++a)
#pragma unroll
        for (int b = 0; b < 2; ++b)
#pragma unroll
            for (int m = 0; m < 4; ++m)
#pragma unroll
                for (int n = 0; n < 2; ++n) acc[a][b][m][n] = (f32x4){0.f, 0.f, 0.f, 0.f};
    bf16x8 At[4][2], B0[2][2], B1[2][2];
    const char* cA = (const char*)g.A + (size_t)cur.pm * tstep; const char* cB = (const char*)g.Bt + (size_t)cur.pn * tstep;
    S.a_ready(cur);
    if constexpr (SP2) {
        PG8_STAGE(PG8_SB(0, 0), cB, voffB); PG8_STAGE(PG8_SB(0, 1), cB + hstep, voffB); PG8_STAGE(PG8_SA(0, 0), cA, voffA); PG8_STAGE(PG8_SA(0, 1), cA + hstep, voffA);
        if (wr == 1) PG8_BAR;
        PG8_WAIT_V(2); PG8_BAR;
        PG8_STAGE(PG8_SB(1, 0), cB + kstep, voffB); PG8_STAGE(PG8_SA(1, 0), cA + kstep, voffA); PG8_STAGE(PG8_SB(1, 1), cB + hstep + kstep, voffB);
        PG8_WAIT_V(6); PG8_BAR;
    } else {
        PG8_STAGE(PG8_SB(0, 0), cB, voffB); PG8_STAGE(PG8_SA(0, 0), cA, voffA); PG8_STAGE(PG8_SB(0, 1), cB + hstep, voffB); PG8_STAGE(PG8_SA(0, 1), cA + hstep, voffA);
        if (wr == 1) PG8_BAR;
        PG8_WAIT_V(4); PG8_BAR;
        PG8_STAGE(PG8_SB(1, 0), cB + kstep, voffB); PG8_STAGE(PG8_SA(1, 0), cA + kstep, voffA); PG8_STAGE(PG8_SB(1, 1), cB + hstep + kstep, voffB);
        PG8_WAIT_V(6); PG8_BAR;
    }
    for (;;) {
        const bool has_next = S.next(ui + 1, nxt);
        const char* nA = has_next ? (const char*)g.A + (size_t)nxt.pm * tstep : cA; const char* nB = has_next ? (const char*)g.Bt + (size_t)nxt.pn * tstep : cB;
        for (int t = 0; t < nt; t += 2) {
            const bool last = (t == nt - 2);
            const char* a1 = cA + (size_t)(t + 1) * kstep;
            const char* a2 = last ? nA : cA + (size_t)(t + 2) * kstep; const char* b2 = last ? nB : cB + (size_t)(t + 2) * kstep;
            const char* a3 = a2 + kstep; const char* b3 = b2 + kstep;
            if (last && has_next) S.a_ready(nxt);
            if constexpr (SP2) {
            PG8_LDB(B0, 0, 0); PG8_LDB(B1, 0, 1); PG8_SCHED; PG8_LDA(At, 0, 0); PG8_STAGE(PG8_SA(1, 1), a1 + hstep, voffA);
            PG8_WAIT_V(8); PG8_WAIT_L(0); PG8_BAR; PG8_MMA(0, 0, At, B0); PG8_MMA(0, 1, At, B1); PG8_BAR; PG8_SCHED;
            PG8_LDA(At, 0, 1); PG8_STAGE(PG8_SB(0, 0), b2, voffB); PG8_STAGE(PG8_SB(0, 1), b2 + hstep, voffB); PG8_STAGE(PG8_SA(0, 0), a2, voffA);
            PG8_WAIT_V(8); PG8_WAIT_L(0); PG8_BAR; PG8_MMA(1, 0, At, B0); PG8_MMA(1, 1, At, B1); PG8_BAR; PG8_SCHED;
            PG8_LDB(B0, 1, 0); PG8_LDB(B1, 1, 1); PG8_SCHED; PG8_LDA(At, 1, 0); PG8_STAGE(PG8_SA(0, 1), a2 + hstep, voffA);
            PG8_WAIT_V(8); PG8_WAIT_L(0); PG8_BAR; PG8_MMA(0, 0, At, B0); PG8_MMA(0, 1, At, B1); PG8_BAR; PG8_SCHED;
            PG8_LDA(At, 1, 1); PG8_STAGE(PG8_SB(1, 0), b3, voffB); PG8_STAGE(PG8_SB(1, 1), b3 + hstep, voffB); PG8_STAGE(PG8_SA(1, 0), a3, voffA);
            PG8_WAIT_V(8); PG8_WAIT_L(0); PG8_BAR; PG8_MMA(1, 0, At, B0); PG8_MMA(1, 1, At, B1); PG8_BAR; PG8_SCHED;
            } else {
            PG8_LDB(B0, 0, 0); PG8_SCHED; PG8_LDA(At, 0, 0); PG8_STAGE(PG8_SA(1, 1), a1 + hstep, voffA);
            PG8_WAIT_L(8); PG8_BAR; PG8_WAIT_L(0); PG8_MMA(0, 0, At, B0); PG8_BAR; PG8_SCHED;
            PG8_LDB(B1, 0, 1); PG8_STAGE(PG8_SB(0, 0), b2, voffB);
            PG8_BAR; PG8_WAIT_L(0); PG8_MMA(0, 1, At, B1); PG8_BAR;
            PG8_LDA(At, 0, 1); PG8_STAGE(PG8_SA(0, 0), a2, voffA);
            PG8_BAR; PG8_WAIT_L(0); PG8_MMA(1, 0, At, B0); PG8_BAR; PG8_SCHED;
            PG8_STAGE(PG8_SB(0, 1), b2 + hstep, voffB);
            PG8_WAIT_V(6); PG8_BAR; PG8_MMA(1, 1, At, B1); PG8_BAR;
            PG8_LDB(B0, 1, 0); PG8_SCHED; PG8_LDA(At, 1, 0); PG8_STAGE(PG8_SA(0, 1), a2 + hstep, voffA);
            PG8_WAIT_L(8); PG8_BAR; PG8_WAIT_L(0); PG8_MMA(0, 0, At, B0); PG8_BAR; PG8_SCHED;
            PG8_LDB(B1, 1, 1); PG8_STAGE(PG8_SB(1, 0), b3, voffB);
            PG8_BAR; PG8_WAIT_L(0); PG8_MMA(0, 1, At, B1); PG8_BAR;
            PG8_LDA(At, 1, 1); PG8_STAGE(PG8_SA(1, 0), a3, voffA);
            PG8_BAR; PG8_WAIT_L(0); PG8_MMA(1, 0, At, B0); PG8_BAR; PG8_SCHED;
            PG8_STAGE(PG8_SB(1, 1), b3 + hstep, voffB);
            PG8_WAIT_V(6); PG8_BAR; PG8_MMA(1, 1, At, B1); PG8_BAR;
            }
        }
        if constexpr (ALIGN_EPI) { if (wr == 0) PG8_BAR; }
        if constexpr (!Epi::AFTER_DRAIN) { E(acc, cur, wr, wc, fr, fq); S.done(cur); }
        if (!has_next) break;
#pragma unroll
        for (int a = 0; a < 2; ++a)
#pragma unroll
            for (int b = 0; b < 2; ++b)
#pragma unroll
                for (int m = 0; m < 4; ++m)
#pragma unroll
                    for (int n = 0; n < 2; ++n) acc[a][b][m][n] = (f32x4){0.f, 0.f, 0.f, 0.f};
        cur = nxt; cA = nA; cB = nB; ++ui;
        if constexpr (ALIGN_EPI) { if (wr == 1) PG8_BAR; }
    }
    PG8_WAIT_V(0);
    if constexpr (!ALIGN_EPI) { if (wr == 0) PG8_BAR; }
    PG8_BAR;
    if constexpr (Epi::AFTER_DRAIN) { E.fused(acc, cur, wr, wc, fr, fq, lds, wid, lane); S.done(cur); }
#undef PG8_SA
#undef PG8_SB
#undef PG8_STAGE
#undef PG8_LDA
#undef PG8_LDB
#undef PG8_MMA
#undef PG8_WAIT_V
#undef PG8_WAIT_L
#undef PG8_BAR
#undef PG8_SCHED
}
}

#define LAS __attribute__((address_space(3)))
typedef unsigned short bf16;
typedef float f32x4 __attribute__((ext_vector_type(4)));
typedef unsigned u32x4 __attribute__((ext_vector_type(4)));
typedef unsigned u32x2 __attribute__((ext_vector_type(2)));
typedef short bf16x8 __attribute__((ext_vector_type(8)));

constexpr int DM = 1024, TP = 16384, TS = 256, MT = TP + TS, FF = 4096, NING = 3072, NINW = 3088;
constexpr int NMOD = 6144, NROWS = 18;
constexpr float EPS = 1e-6f;
constexpr float LOG2E = 1.4426950408889634f;
constexpr float QSCALE = 0.125f * LOG2E;

constexpr size_t OUT_KP = 17039360, OUT_VP = 33816576, OUT_SP = 50593792, OUT_KS = 50724864, OUT_VS = 50987008, OUT_SS = 51249152;
constexpr size_t MiB = 1u << 20;
constexpr size_t WS_CTL = 0, WS_WIN = 1 * MiB, WS_WOUT = 13 * MiB, WS_WUP = 17 * MiB, WS_WDN = 33 * MiB, WS_MOD = 49 * MiB, WS_H = 50 * MiB,
                 WS_Q = 83 * MiB, WS_QG = 100 * MiB, WS_KG = 109 * MiB, WS_VG = 118 * MiB, WS_OG = 135 * MiB, WS_LOGF = 152 * MiB,
                 WS_MERGED = 169 * MiB, WS_U = 202 * MiB, WS_ACH = 234 * MiB, WS_S = 235 * MiB, WS_BIASIN = 267 * MiB, WS_BIASGR = 267 * MiB + 512 * 1024, WS_WGR = 267 * MiB + 576 * 1024, WS_END = 268 * MiB, WS_UU = WS_Q;
constexpr int LDS_BYTES = 147456, ARGS_OFF = 131072 + 1024;
constexpr size_t WS_ROWSS = 131072, WS_ROWSS_IN = 131072 + 2 * 16640 * 4, CTL_ZERO_BYTES = 131072 + 4 * 16640 * 4;
constexpr size_t WS_BIASUP = 234 * MiB + 384 * 1024;

struct Args { const float* in[20]; float* out; unsigned char* ws; int never; int pad; };

__device__ __forceinline__ unsigned f2bf(float f) { unsigned u = __builtin_bit_cast(unsigned, f); return (u + 0x7fffu + ((u >> 16) & 1u)) >> 16; }
__device__ __forceinline__ unsigned pk2(float lo, float hi) { return pg8::cvt_pk_bf16(lo, hi); }
__device__ __forceinline__ float bf2f(unsigned short b) { return __builtin_bit_cast(float, (unsigned)b << 16); }
__device__ __forceinline__ float bflo(unsigned w) { return __builtin_bit_cast(float, w << 16); }
__device__ __forceinline__ float bfhi(unsigned w) { return __builtin_bit_cast(float, w & 0xffff0000u); }
__device__ __forceinline__ bf16x8 pack8(f32x4 a, f32x4 b) { u32x4 w; w.x = pk2(a.x, a.y); w.y = pk2(a.z, a.w); w.z = pk2(b.x, b.y); w.w = pk2(b.z, b.w); return __builtin_bit_cast(bf16x8, w); }
__device__ __forceinline__ float wave_sum(float v) {
#pragma unroll
    for (int o = 1; o < 64; o <<= 1) v += __shfl_xor(v, o);
    return v;
}
__device__ __forceinline__ int modrow(int m) { return m < TP ? (m >> 13) : 2 + ((m - TP) >> 4); }
__device__ __forceinline__ float silu_f(float x) { return x / (1.f + __expf(-x)); }
__device__ __forceinline__ void* ld_ptr(LAS unsigned char* p) { const unsigned lo = *(volatile LAS unsigned*)p, hi = *(volatile LAS unsigned*)(p + 4);
    return (void*)(((unsigned long long)(unsigned)__builtin_amdgcn_readfirstlane((int)hi) << 32) | (unsigned)__builtin_amdgcn_readfirstlane((int)lo)); }
#ifndef WT_STORES
#define WT_STORES 0
#endif
__device__ __forceinline__ void st16(void* ptr, u32x4 v) {
#if WT_STORES
    asm volatile("global_store_dwordx4 %0, %1, off sc1\n\ts_nop 1" :: "v"(ptr), "v"(v));
#else
    *(u32x4*)ptr = v;
#endif
}
__device__ __forceinline__ void st16(void* ptr, f32x4 v) { st16(ptr, __builtin_bit_cast(u32x4, v)); }
#define LDS_WAIT() asm volatile("s_waitcnt lgkmcnt(0)" ::: "memory")
#define MFMA16(a, b, c) __builtin_amdgcn_mfma_f32_16x16x32_bf16((a), (b), (c), 0, 0, 0)

struct EpiIn {
    static constexpr bool PERM = true, AFTER_DRAIN = false;
    int l; float* out; bf16 *Q, *QG, *KG, *VG, *OG; const float *qn, *kn; const float* rowss; const float* bias;
    __device__ __forceinline__ void operator()(const pg8::f32x4 (&acc0)[2][2][4][2], const pg8::Unit& u, int wr, int wc, int fr, int fq) const {
        const int pn = u.pn;
        f32x4 bv[2][2];
        { const float* bp = bias + (size_t)((u.pm * 256) >> 13) * NING + 256 * pn + 64 * wc + 8 * fq;
#pragma unroll
          for (int bj = 0; bj < 2; ++bj)
#pragma unroll
              for (int n = 0; n < 2; ++n) bv[bj][n] = *(const f32x4*)(bp + 32 * bj + 4 * n); }
        f32x4 nw[2][2];
        if (pn < 4) {
            const float* np = (pn < 2 ? qn : kn) + 8 * fq;
#pragma unroll
            for (int bj = 0; bj < 2; ++bj)
#pragma unroll
                for (int n = 0; n < 2; ++n) nw[bj][n] = *(const f32x4*)(np + 32 * bj + 4 * n);
        }
#pragma unroll
        for (int ai = 0; ai < 2; ++ai)
#pragma unroll
            for (int m = 0; m < 4; ++m) {
                const int row = u.pm * 256 + ai * 128 + wr * 64 + m * 16 + fr;
                const int cin = 64 * wc + 8 * fq;
                const float rs0 = rsqrtf(rowss[row] * (1.f / DM) + EPS);
                f32x4 av[2][2];
#pragma unroll
                for (int bj = 0; bj < 2; ++bj)
#pragma unroll
                    for (int n = 0; n < 2; ++n) av[bj][n] = acc0[ai][bj][m][n] * rs0 + bv[bj][n];
                if (pn < 4) {
                    float ss = 0.f;
#pragma unroll
                    for (int bj = 0; bj < 2; ++bj)
#pragma unroll
                        for (int n = 0; n < 2; ++n) { const f32x4 v = av[bj][n]; ss += (v.x * v.x + v.y * v.y) + (v.z * v.z + v.w * v.w); }
                    ss += __shfl_xor(ss, 16); ss += __shfl_xor(ss, 32);
                    const float rstd = rsqrtf(ss * (1.f / 64.f) + EPS);
                    if (pn < 2) {
                        bf16* qp = Q + (size_t)row * 512 + 256 * pn + cin;
#pragma unroll
                        for (int bj = 0; bj < 2; ++bj) {
                            const f32x4 a = av[bj][0] * nw[bj][0] * (rstd * QSCALE), b = av[bj][1] * nw[bj][1] * (rstd * QSCALE);
                            u32x4 w; w.x = pk2(a.x, a.y); w.y = pk2(a.z, a.w); w.z = pk2(b.x, b.y); w.w = pk2(b.z, b.w);
                            st16(qp + 32 * bj, w);
                        }
                    } else {
                        float* kp = (row < TP ? out + OUT_KP + ((size_t)l * TP + row) * 512 : out + OUT_KS + ((size_t)l * TS + (row - TP)) * 512) + 256 * (pn - 2) + cin;
#pragma unroll
                        for (int bj = 0; bj < 2; ++bj)
#pragma unroll
                            for (int n = 0; n < 2; ++n) st16(kp + 32 * bj + 4 * n, (f32x4)(av[bj][n] * nw[bj][n] * rstd));
                    }
                } else if (pn < 6) {
                    float* vp = (row < TP ? out + OUT_VP + ((size_t)l * TP + row) * 512 : out + OUT_VS + ((size_t)l * TS + (row - TP)) * 512) + 256 * (pn - 4) + cin;
#pragma unroll
                    for (int bj = 0; bj < 2; ++bj)
#pragma unroll
                        for (int n = 0; n < 2; ++n) st16(vp + 32 * bj + 4 * n, (f32x4)(av[bj][n]));
                } else {
                    bf16* dp; float sc = 1.f;
                    if (pn == 6) { dp = QG + (size_t)row * 256 + cin; sc = 0.125f; }
                    else if (pn == 7) dp = KG + (size_t)row * 256 + cin;
                    else if (pn < 10) dp = VG + (size_t)row * 512 + 256 * (pn - 8) + cin;
                    else dp = OG + (size_t)row * 512 + 256 * (pn - 10) + cin;
#pragma unroll
                    for (int bj = 0; bj < 2; ++bj) {
                        const f32x4 a = av[bj][0] * sc, b = av[bj][1] * sc;
                        u32x4 w; w.x = pk2(a.x, a.y); w.y = pk2(a.z, a.w); w.z = pk2(b.x, b.y); w.w = pk2(b.z, b.w);
                        st16(dp + 32 * bj, w);
                    }
                }
            }
    }
};
struct EpiRes {
    static constexpr bool PERM = false, AFTER_DRAIN = false;
    const float* srcp; const float* srcs; float* X; const float* gate;
    __device__ __forceinline__ void operator()(const pg8::f32x4 (&acc)[2][2][4][2], const pg8::Unit& u, int wr, int wc, int fr, int fq) const {
        const int col0 = u.pn * 256 + wc * 32 + 4 * fq;
#pragma unroll
        for (int ai = 0; ai < 2; ++ai)
#pragma unroll
            for (int m = 0; m < 4; ++m) {
                const int row = u.pm * 256 + ai * 128 + wr * 64 + m * 16 + fr;
                const float* sp = (row < TP ? srcp + (size_t)row * DM : srcs + (size_t)(row - TP) * DM) + col0;
                const float* gp = gate + (size_t)modrow(row) * NMOD + col0;
                float* xp = X + (size_t)row * DM + col0;
#pragma unroll
                for (int bj = 0; bj < 2; ++bj)
#pragma unroll
                    for (int n = 0; n < 2; ++n) {
                        const f32x4 s = *(const f32x4*)(sp + bj * 128 + n * 16), g = *(const f32x4*)(gp + bj * 128 + n * 16);
                        st16(xp + bj * 128 + n * 16, (f32x4)(s + g * acc[ai][bj][m][n]));
                    }
            }
    }
};
struct EpiUp {
    static constexpr bool PERM = true, AFTER_DRAIN = false;
    bf16* O;
    __device__ __forceinline__ void operator()(const pg8::f32x4 (&acc)[2][2][4][2], const pg8::Unit& u, int wr, int wc, int fr, int fq) const {
        const int col0 = u.pn * 256 + wc * 32 + 8 * fq;
#pragma unroll
        for (int ai = 0; ai < 2; ++ai)
#pragma unroll
            for (int m = 0; m < 4; ++m) {
                bf16* rp = O + (size_t)(u.pm * 256 + ai * 128 + wr * 64 + m * 16 + fr) * FF + col0;
#pragma unroll
                for (int bj = 0; bj < 2; ++bj) {
                    f32x4 a = acc[ai][bj][m][0], b = acc[ai][bj][m][1];
                    a = __builtin_elementwise_max(a, (f32x4){0.f, 0.f, 0.f, 0.f}); b = __builtin_elementwise_max(b, (f32x4){0.f, 0.f, 0.f, 0.f});
                    a = a * a; b = b * b;
                    u32x4 w; w.x = pk2(a.x, a.y); w.y = pk2(a.z, a.w); w.z = pk2(b.x, b.y); w.w = pk2(b.z, b.w);
                    st16(rp + bj * 128, w);
                }
            }
    }
};

struct EpiResN {
    static constexpr bool PERM = true, AFTER_DRAIN = false;
    const float* srcp; float* X; const float* gate; const float* nw; const float* scl; bf16* Hout; float* rowss;
    __device__ __forceinline__ void operator()(const pg8::f32x4 (&acc)[2][2][4][2], const pg8::Unit& u, int wr, int wc, int fr, int fq) const {
        const int col0 = u.pn * 256 + wc * 32 + 8 * fq;
        const int mr = (u.pm * 256) >> 13;
        f32x4 wm[2][2], gv[2][2];
#pragma unroll
        for (int bj = 0; bj < 2; ++bj)
#pragma unroll
            for (int n = 0; n < 2; ++n) { const int c = col0 + bj * 128 + 4 * n;
                wm[bj][n] = Hout ? *(const f32x4*)(nw + c) * (*(const f32x4*)(scl + (size_t)mr * NMOD + c) + 1.0f) : (f32x4){0.f, 0.f, 0.f, 0.f}; gv[bj][n] = *(const f32x4*)(gate + (size_t)mr * NMOD + c); }
#pragma unroll
        for (int ai = 0; ai < 2; ++ai)
#pragma unroll
            for (int m = 0; m < 4; ++m) {
                const int row = u.pm * 256 + ai * 128 + wr * 64 + m * 16 + fr;
                const float* sp = srcp + (size_t)row * DM + col0; float* xp = X + (size_t)row * DM + col0; bf16* hp = Hout + (size_t)row * DM + col0;
                float ss = 0.f;
#pragma unroll
                for (int bj = 0; bj < 2; ++bj) {
                    const f32x4 x0 = *(const f32x4*)(sp + bj * 128) + gv[bj][0] * acc[ai][bj][m][0], x1 = *(const f32x4*)(sp + bj * 128 + 4) + gv[bj][1] * acc[ai][bj][m][1];
                    st16(xp + bj * 128, (f32x4)(x0)); st16(xp + bj * 128 + 4, (f32x4)(x1));
                    ss += (x0.x * x0.x + x0.y * x0.y) + (x0.z * x0.z + x0.w * x0.w) + (x1.x * x1.x + x1.y * x1.y) + (x1.z * x1.z + x1.w * x1.w);
                    if (Hout) { const f32x4 h0 = x0 * wm[bj][0], h1 = x1 * wm[bj][1];
                    u32x4 w; w.x = pk2(h0.x, h0.y); w.y = pk2(h0.z, h0.w); w.z = pk2(h1.x, h1.y); w.w = pk2(h1.z, h1.w);
                    st16(hp + bj * 128, w); }
                }
                ss += __shfl_xor(ss, 16); ss += __shfl_xor(ss, 32);
                if (Hout && fq == 0) unsafeAtomicAdd(rowss + row, ss);
            }
    }
};
struct EpiUpN {
    static constexpr bool PERM = true, AFTER_DRAIN = false;
    bf16* O; const float* rowss; const float* bias;
    __device__ __forceinline__ void operator()(const pg8::f32x4 (&acc)[2][2][4][2], const pg8::Unit& u, int wr, int wc, int fr, int fq) const {
        const int col0 = u.pn * 256 + wc * 32 + 8 * fq;
        const int mr = (u.pm * 256) >> 13;
        f32x4 bv[2][2];
#pragma unroll
        for (int bj = 0; bj < 2; ++bj)
#pragma unroll
            for (int n = 0; n < 2; ++n) bv[bj][n] = *(const f32x4*)(bias + (size_t)mr * FF + col0 + bj * 128 + 4 * n);
#pragma unroll
        for (int ai = 0; ai < 2; ++ai)
#pragma unroll
            for (int m = 0; m < 4; ++m) {
                const int row = u.pm * 256 + ai * 128 + wr * 64 + m * 16 + fr;
                const float rstd = rsqrtf(rowss[row] * (1.f / DM) + EPS);
                bf16* rp = O + (size_t)row * FF + col0;
#pragma unroll
                for (int bj = 0; bj < 2; ++bj) {
                    f32x4 a = acc[ai][bj][m][0] * rstd + bv[bj][0], b = acc[ai][bj][m][1] * rstd + bv[bj][1];
                    a = __builtin_elementwise_max(a, (f32x4){0.f, 0.f, 0.f, 0.f}); b = __builtin_elementwise_max(b, (f32x4){0.f, 0.f, 0.f, 0.f});
                    a = a * a; b = b * b;
                    u32x4 w; w.x = pk2(a.x, a.y); w.y = pk2(a.z, a.w); w.z = pk2(b.x, b.y); w.w = pk2(b.z, b.w);
                    st16(rp + bj * 128, w);
                }
            }
    }
};

__device__ __forceinline__ void transpose_item(const float* W, int ldw, int k0, int c0, bf16* WT, int K, int r0, LAS float* scr, int lane) {
#pragma unroll 8
    for (int i = 0; i < 32; ++i) { const int kk = 2 * i + (lane >> 5); scr[kk * 33 + (lane & 31)] = W[(size_t)(k0 + kk) * ldw + c0 + (lane & 31)]; }
    LDS_WAIT();
    const int c = lane & 7;
#pragma unroll
    for (int j = 0; j < 4; ++j) { const int n = (lane >> 3) + 8 * j; const LAS float* s = scr + (8 * c) * 33 + n;
        u32x4 o; o.x = pk2(s[0 * 33], s[1 * 33]); o.y = pk2(s[2 * 33], s[3 * 33]); o.z = pk2(s[4 * 33], s[5 * 33]); o.w = pk2(s[6 * 33], s[7 * 33]);
        *(u32x4*)(WT + (size_t)(r0 + n) * K + k0 + 8 * c) = o; }
    LDS_WAIT();
}

__device__ __forceinline__ void gemv18_item(LAS float* sc, LAS float* red, const float* W, int ldw, int n0, float* out, int ostride, const float* addv, int tid, int lane, int wave) {
    const int ksub = lane >> 4, c4 = (lane & 15) * 4;
    f32x4 acc[18];
#pragma unroll
    for (int r = 0; r < 18; ++r) acc[r] = (f32x4){0.f, 0.f, 0.f, 0.f};
    const float* wbase = W + (size_t)(wave * 128 + ksub) * ldw + n0 + c4;
#pragma unroll 4
    for (int st = 0; st < 32; ++st) {
        const f32x4 wv = *(const f32x4*)(wbase + (size_t)st * 4 * ldw);
        const LAS f32x4* sp = (const LAS f32x4*)(sc + (wave * 128 + st * 4 + ksub) * 20);
        const f32x4 s0 = sp[0], s1 = sp[1], s2 = sp[2], s3 = sp[3], s4 = sp[4];
        acc[0] += s0.x * wv; acc[1] += s0.y * wv; acc[2] += s0.z * wv; acc[3] += s0.w * wv;
        acc[4] += s1.x * wv; acc[5] += s1.y * wv; acc[6] += s1.z * wv; acc[7] += s1.w * wv;
        acc[8] += s2.x * wv; acc[9] += s2.y * wv; acc[10] += s2.z * wv; acc[11] += s2.w * wv;
        acc[12] += s3.x * wv; acc[13] += s3.y * wv; acc[14] += s3.z * wv; acc[15] += s3.w * wv;
        acc[16] += s4.x * wv; acc[17] += s4.y * wv;
    }
#pragma unroll
    for (int r = 0; r < 18; ++r) {
#pragma unroll
        for (int j = 0; j < 4; ++j) { float v = acc[r][j]; v += __shfl_xor(v, 16); v += __shfl_xor(v, 32); acc[r][j] = v; }
        if (lane < 16) *(LAS f32x4*)(red + (wave * 18 + r) * 64 + c4) = acc[r];
    }
    __syncthreads();
    for (int idx = tid; idx < 1152; idx += 512) { const int r = idx >> 6, c = idx & 63; float s = addv ? addv[n0 + c] : 0.f;
#pragma unroll
        for (int w = 0; w < 8; ++w) s += red[(w * 18 + r) * 64 + c];
        out[(size_t)r * ostride + n0 + c] = s; }
    __syncthreads();
}

__device__ __forceinline__ void phase_prologue(const Args& a, LAS unsigned char* lds, int tid, int lane, int wave, int G, int bid) {
    const float* cp = a.in[2]; const float* cs = a.in[3]; const float* w_ada = a.in[7]; const float* b_ada = a.in[8];
    float* mod = (float*)(a.ws + WS_MOD);
    LAS float* sc = (LAS float*)lds;
    LAS float* red = (LAS float*)(lds + 81920);
    if (bid < 192) {
        for (int idx = tid; idx < 20 * 1024; idx += 512) { const int r = idx >> 10, k = idx & 1023; float v = 0.f;
            if (r < 18) { const float c = r < 2 ? cp[r * 1024 + k] : cs[(r - 2) * 1024 + k]; v = silu_f(c); }
            sc[k * 20 + r] = v; }
        __syncthreads();
        for (int it = bid; it < 192; it += G) {
            const int l = it / 96, n0 = (it % 96) * 64;
            gemv18_item(sc, red, w_ada + (size_t)l * 1024 * NMOD, NMOD, n0, mod + (size_t)l * NROWS * NMOD, NMOD, b_ada + l * NMOD, tid, lane, wave);
        }
    }
}

__device__ __forceinline__ void weight_copies(const Args& a, LAS unsigned char* lds, int lane, int wave, int G, int bid) {
    LAS float* scr = (LAS float*)(lds + wave * 16384);
    const int vb = (bid + 30) % G, gw = vb * 8 + wave, NGW = G * 8;
    bf16* WIN = (bf16*)(a.ws + WS_WIN); bf16* WOUT = (bf16*)(a.ws + WS_WOUT); bf16* WUP = (bf16*)(a.ws + WS_WUP); bf16* WDN = (bf16*)(a.ws + WS_WDN);
    for (int it = gw; it < 12288 + 32; it += NGW) {
        if (it >= 12288) { const int r2 = it - 12288, l2 = r2 >> 4, kb = r2 & 15;
            transpose_item(a.in[11] + (size_t)l2 * DM * NINW, NINW, 64 * kb, 2560, (bf16*)(a.ws + WS_WGR) + (size_t)l2 * 32 * DM, DM, 0, scr, lane); continue; }
        const int l = it / 6144; int r = it % 6144;
        if (r < 1536) { const int kb = r / 96, nb = r % 96, pn = nb >> 3, q = nb & 7, bj = q >> 2, wc = q & 3, oc = 256 * pn + 64 * wc + 32 * bj, src = oc < 2560 ? oc : oc + 16;
            transpose_item(a.in[11] + (size_t)l * DM * NINW, NINW, 64 * kb, src, WIN + (size_t)l * NING * DM, DM, 32 * nb, scr, lane); }
        else if (r < 2048) { r -= 1536; const int kb = r / 32, nb = r % 32;
            transpose_item(a.in[17] + (size_t)l * DM * DM, DM, 64 * kb, 32 * nb, WOUT + (size_t)l * DM * DM, DM, 32 * nb, scr, lane); }
        else if (r < 4096) { r -= 2048; const int kb = r / 128, nb = r % 128;
            transpose_item(a.in[18] + (size_t)l * DM * FF, FF, 64 * kb, 32 * nb, WUP + (size_t)l * FF * DM, DM, 32 * nb, scr, lane); }
        else { r -= 4096; const int kb = r / 32, nb = r % 32;
            transpose_item(a.in[19] + (size_t)l * FF * DM, DM, 64 * kb, 32 * nb, WDN + (size_t)l * DM * FF, FF, 32 * nb, scr, lane); }
    }
}

__device__ __forceinline__ void prep_rows(const Args& a, int m0, int nrow, int lane) {
    const float* mod = (const float*)(a.ws + WS_MOD); const float* nw = a.in[9];
    bf16* H = (bf16*)(a.ws + WS_H); float* rowss = (float*)(a.ws + WS_ROWSS_IN);
    f32x4 wmv[4];
    { const float* mr = mod + (size_t)modrow(m0) * NMOD + 4 * lane;
#pragma unroll
      for (int j = 0; j < 4; ++j) wmv[j] = *(const f32x4*)(nw + 4 * lane + 256 * j) * (*(const f32x4*)(mr + DM + 256 * j) + 1.0f); }
    for (int rr = 0; rr < nrow; ++rr) {
        const int m = m0 + rr;
        const float* xr = (m < TP ? a.in[0] + (size_t)m * DM : a.in[1] + (size_t)(m - TP) * DM) + 4 * lane;
        f32x4 v[4]; float ss = 0.f;
#pragma unroll
        for (int j = 0; j < 4; ++j) { v[j] = *(const f32x4*)(xr + 256 * j); ss += (v[j].x * v[j].x + v[j].y * v[j].y) + (v[j].z * v[j].z + v[j].w * v[j].w); }
        ss = wave_sum(ss);
        if (lane == 0) rowss[m] = ss;
        bf16* hr = H + (size_t)m * DM + 4 * lane;
#pragma unroll
        for (int j = 0; j < 4; ++j) { const f32x4 o = v[j] * wmv[j]; u32x2 pk; pk.x = pk2(o.x, o.y); pk.y = pk2(o.z, o.w); *(u32x2*)(hr + 256 * j) = pk; }
    }
}
__device__ __forceinline__ void prep_phase(const Args& a, LAS unsigned char* lds, int tid, int lane, int wave, int G, int bid) {
    const float* mod = (const float*)(a.ws + WS_MOD);
    {
        LAS float* sc = (LAS float*)lds; LAS float* red = (LAS float*)(lds + 81920);
        for (int it = bid; it < 226; it += G) {
            const int ll = it / 113, j = it % 113;
            const float* mm = mod + (size_t)ll * NROWS * NMOD + ((j >= 48 && j < 112) ? 3 * DM : 0);
            for (int idx = tid; idx < 20 * 1024; idx += 512) { const int r = idx >> 10, k = idx & 1023; sc[k * 20 + r] = r < 18 ? mm[(size_t)r * NMOD + k] : 0.f; }
            __syncthreads();
            if (j < 48) gemv18_item(sc, red, a.in[11] + (size_t)ll * DM * NINW + (64 * j < 2560 ? 64 * j : 64 * j + 16), NINW, 0, (float*)(a.ws + WS_BIASIN) + (size_t)ll * NROWS * NING + 64 * j, NING, nullptr, tid, lane, wave);
            else if (j < 112) gemv18_item(sc, red, a.in[18] + (size_t)ll * DM * FF + 64 * (j - 48), FF, 0, (float*)(a.ws + WS_BIASUP) + (size_t)ll * NROWS * FF + 64 * (j - 48), FF, nullptr, tid, lane, wave);
            else gemv18_item(sc, red, a.in[11] + (size_t)ll * DM * NINW + 2560, NINW, 0, (float*)(a.ws + WS_BIASGR) + (size_t)ll * NROWS * 64, 64, nullptr, tid, lane, wave);
        }
        __syncthreads();
    }
    weight_copies(a, lds, lane, wave, G, bid);
    const int gw = bid * 8 + wave, NGW = G * 8;
    for (int gi = gw; gi < TP / 2; gi += NGW) prep_rows(a, 2 * gi, 2, lane);
    if (wave == 0) for (int s = bid; s < TS; s += G) prep_rows(a, TP + s, 1, lane);
}

template <int TN, int K, bool PERMIN>
__device__ __forceinline__ void sg_compute(f32x4 (&acc)[2][TN / 16], const bf16* A, const bf16* Bt, int rt, int ct, int lane, int wave) {
    constexpr int NCB = TN / 16, KW = K / 8;
    const int fr = lane & 15, fq = lane >> 4;
#pragma unroll
    for (int i = 0; i < 2; ++i)
#pragma unroll
        for (int j = 0; j < NCB; ++j) acc[i][j] = (f32x4){0.f, 0.f, 0.f, 0.f};
    const bf16* ap = A + (size_t)(32 * rt + fr) * K + wave * KW + 8 * fq;
    const bf16* bp[NCB];
#pragma unroll
    for (int cb = 0; cb < NCB; ++cb) {
        int row;
        if (PERMIN) { const int pn = ct >> 2, wc = ct & 3; row = 256 * pn + 128 * (cb >> 1) + 32 * wc + 16 * (cb & 1) + fr; }
        else row = ct * TN + 16 * cb + fr;
        bp[cb] = Bt + (size_t)row * K + wave * KW + 8 * fq;
    }
#pragma unroll 4
    for (int ks = 0; ks < KW / 32; ++ks) {
        const bf16x8 a0 = *(const bf16x8*)(ap + 32 * ks), a1 = *(const bf16x8*)(ap + (size_t)16 * K + 32 * ks);
#pragma unroll
        for (int cb = 0; cb < NCB; ++cb) {
            const bf16x8 bfr = *(const bf16x8*)(bp[cb] + 32 * ks);
            acc[0][cb] = MFMA16(bfr, a0, acc[0][cb]); acc[1][cb] = MFMA16(bfr, a1, acc[1][cb]);
        }
    }
}
template <int TN, class Epi>
__device__ __forceinline__ void sg_finish(LAS unsigned char* lds, const f32x4 (&acc)[2][TN / 16], int rt, int ct, const Epi& E, int tid, int lane, int wave) {
    constexpr int NCB = TN / 16, NB = 2 * NCB, PW = NB * 1088;
    const int fr = lane & 15, fq = lane >> 4;
#pragma unroll
    for (int rb = 0; rb < 2; ++rb)
#pragma unroll
        for (int cb = 0; cb < NCB; ++cb) *(LAS f32x4*)(lds + wave * PW + (rb * NCB + cb) * 1088 + fq * 272 + fr * 16) = acc[rb][cb];
    __syncthreads();
    {
        const int r = tid >> 4, q = tid & 15;
        f32x4 v = (f32x4){0.f, 0.f, 0.f, 0.f};
        if (q < TN / 4) {
            const int off = ((r >> 4) * NCB + (q >> 2)) * 1088 + (q & 3) * 272 + (r & 15) * 16;
#pragma unroll
            for (int w = 0; w < 8; ++w) v += *(const LAS f32x4*)(lds + w * PW + off);
        }
        if (q < TN / 4) v = E.pre(TP + 32 * rt + r, ct * TN + 4 * q, v);
        float ss = (v.x * v.x + v.y * v.y) + (v.z * v.z + v.w * v.w);
        ss += __shfl_xor(ss, 1); ss += __shfl_xor(ss, 2); ss += __shfl_xor(ss, 4); ss += __shfl_xor(ss, 8);
        if (q < TN / 4) E(TP + 32 * rt + r, ct * TN + 4 * q, v, ss);
    }
    __syncthreads();
}
template <int TN, int K, bool PERMIN, class Epi>
__device__ __forceinline__ void small_gemm(LAS unsigned char* lds, const bf16* A, const bf16* Bt, int ntiles, const Epi& E, int tid, int lane, int wave, int bid, int G) {
    for (int it = bid; it < ntiles; it += 2 * G) {
        const bool two = it + G < ntiles; const int it1 = two ? it + G : it;
        f32x4 acc0[2][TN / 16], acc1[2][TN / 16];
        if (two) {
            sg_compute<TN, K, PERMIN>(acc0, A, Bt, it & 7, it >> 3, lane, wave);
            sg_compute<TN, K, PERMIN>(acc1, A, Bt, it1 & 7, it1 >> 3, lane, wave);
            sg_finish<TN, Epi>(lds, acc0, it & 7, it >> 3, E, tid, lane, wave);
            sg_finish<TN, Epi>(lds, acc1, it1 & 7, it1 >> 3, E, tid, lane, wave);
        } else {
            sg_compute<TN, K, PERMIN>(acc0, A, Bt, it & 7, it >> 3, lane, wave);
            sg_finish<TN, Epi>(lds, acc0, it & 7, it >> 3, E, tid, lane, wave);
        }
    }
}
struct SIn {
    int l; float* out; bf16 *Q, *QG, *KG, *VG, *OG; const float *qn, *kn; const float* rowss; const float* bias;
    __device__ __forceinline__ f32x4 pre(int m, int col, f32x4 v) const { return v * rsqrtf(rowss[m] * (1.f / DM) + EPS) + *(const f32x4*)(bias + (size_t)modrow(m) * NING + col); }
    template <int NCB> __device__ __forceinline__ void row(int m, int colbase, const f32x4 (&acc)[NCB]) const {
        float ss = 0.f;
#pragma unroll
        for (int cb = 0; cb < NCB; ++cb) ss += (acc[cb].x * acc[cb].x + acc[cb].y * acc[cb].y) + (acc[cb].z * acc[cb].z + acc[cb].w * acc[cb].w);
        ss += __shfl_xor(ss, 16); ss += __shfl_xor(ss, 32);
#pragma unroll
        for (int cb = 0; cb < NCB; ++cb) (*this)(m, colbase + 16 * cb, acc[cb], ss);
    }
    __device__ __forceinline__ void operator()(int m, int col, f32x4 v, float ss) const {
        const int pn = col >> 8; const size_t ms = (size_t)l * TS + (m - TP);
        if (pn < 4) {
            const float rstd = rsqrtf(ss * (1.f / 64.f) + EPS);
            const f32x4 w = *(const f32x4*)((pn < 2 ? qn : kn) + (col & 63));
            if (pn < 2) { const f32x4 o = v * w * (rstd * QSCALE); u32x2 p; p.x = pk2(o.x, o.y); p.y = pk2(o.z, o.w); *(u32x2*)(Q + (size_t)m * 512 + col) = p; }
            else *(f32x4*)(out + OUT_KS + ms * 512 + (col - 512)) = v * w * rstd;
        } else if (pn < 6) *(f32x4*)(out + OUT_VS + ms * 512 + (col - 1024)) = v;
        else {
            bf16* dp; float sc = 1.f;
            if (pn == 6) { dp = QG + (size_t)m * 256 + (col - 1536); sc = 0.125f; }
            else if (pn == 7) dp = KG + (size_t)m * 256 + (col - 1792);
            else if (pn < 10) dp = VG + (size_t)m * 512 + (col - 2048);
            else dp = OG + (size_t)m * 512 + (col - 2560);
            u32x2 p; p.x = pk2(v.x * sc, v.y * sc); p.y = pk2(v.z * sc, v.w * sc); *(u32x2*)dp = p;
        }
    }
};
struct SRes {
    const float* srcs; float* X; const float* gate;
    __device__ __forceinline__ f32x4 pre(int, int, f32x4 v) const { return v; }
    __device__ __forceinline__ void operator()(int m, int col, f32x4 v, float) const {
        const f32x4 s = *(const f32x4*)(srcs + (size_t)(m - TP) * DM + col), g = *(const f32x4*)(gate + (size_t)modrow(m) * NMOD + col);
        *(f32x4*)(X + (size_t)m * DM + col) = s + g * v;
    }
};
struct SUp {
    bf16* O;
    __device__ __forceinline__ f32x4 pre(int, int, f32x4 v) const { return v; }
    __device__ __forceinline__ void operator()(int m, int col, f32x4 v, float) const {
        v = __builtin_elementwise_max(v, (f32x4){0.f, 0.f, 0.f, 0.f}); v = v * v;
        u32x2 p; p.x = pk2(v.x, v.y); p.y = pk2(v.z, v.w); *(u32x2*)(O + (size_t)m * FF + col) = p;
    }
};

struct SResN {
    const float* srcs; float* X; const float* gate; const float* nw; const float* scl; bf16* Hout; float* rowss;
    __device__ __forceinline__ f32x4 pre(int, int, f32x4 v) const { return v; }
    template <int NCB> __device__ __forceinline__ void row(int m, int colbase, const f32x4 (&acc)[NCB]) const {
        const int mr = modrow(m); float ss = 0.f;
#pragma unroll
        for (int cb = 0; cb < NCB; ++cb) { const int col = colbase + 16 * cb;
            const f32x4 x = *(const f32x4*)(srcs + (size_t)(m - TP) * DM + col) + *(const f32x4*)(gate + (size_t)mr * NMOD + col) * acc[cb];
            *(f32x4*)(X + (size_t)m * DM + col) = x;
            if (Hout) { const f32x4 h = x * *(const f32x4*)(nw + col) * (*(const f32x4*)(scl + (size_t)mr * NMOD + col) + 1.0f);
                u32x2 pq; pq.x = pk2(h.x, h.y); pq.y = pk2(h.z, h.w); *(u32x2*)(Hout + (size_t)m * DM + col) = pq; }
            ss += (x.x * x.x + x.y * x.y) + (x.z * x.z + x.w * x.w); }
        ss += __shfl_xor(ss, 16); ss += __shfl_xor(ss, 32);
        if (Hout && (colbase & 15) == 0) unsafeAtomicAdd(rowss + m, ss);
    }
    __device__ __forceinline__ void operator()(int m, int col, f32x4 v, float) const {
        const int mr = modrow(m);
        const f32x4 x = *(const f32x4*)(srcs + (size_t)(m - TP) * DM + col) + *(const f32x4*)(gate + (size_t)mr * NMOD + col) * v;
        *(f32x4*)(X + (size_t)m * DM + col) = x;
        if (Hout) { const f32x4 h = x * *(const f32x4*)(nw + col) * (*(const f32x4*)(scl + (size_t)mr * NMOD + col) + 1.0f);
        u32x2 p; p.x = pk2(h.x, h.y); p.y = pk2(h.z, h.w); *(u32x2*)(Hout + (size_t)m * DM + col) = p; }
        float ss = (x.x * x.x + x.y * x.y) + (x.z * x.z + x.w * x.w);
        ss += __shfl_xor(ss, 1); ss += __shfl_xor(ss, 2); ss += __shfl_xor(ss, 4);
        if (Hout && ((col >> 2) & 7) == 0) unsafeAtomicAdd(rowss + m, ss);
    }
};
struct SUpN {
    bf16* O; const float* rowss; const float* bias;
    __device__ __forceinline__ f32x4 pre(int, int, f32x4 v) const { return v; }
    template <int NCB> __device__ __forceinline__ void row(int m, int colbase, const f32x4 (&acc)[NCB]) const {
#pragma unroll
        for (int cb = 0; cb < NCB; ++cb) (*this)(m, colbase + 16 * cb, acc[cb], 0.f);
    }
    __device__ __forceinline__ void operator()(int m, int col, f32x4 v, float) const {
        const float rstd = rsqrtf(rowss[m] * (1.f / DM) + EPS);
        v = v * rstd + *(const f32x4*)(bias + (size_t)modrow(m) * FF + col);
        v = __builtin_elementwise_max(v, (f32x4){0.f, 0.f, 0.f, 0.f}); v = v * v;
        u32x2 p; p.x = pk2(v.x, v.y); p.y = pk2(v.z, v.w); *(u32x2*)(O + (size_t)m * FF + col) = p;
    }
};


__device__ __forceinline__ void gate_finish(LAS unsigned char* lds, const f32x4 (&acc)[2][1], int rt, const float* rowss, const float* biasgr, const float* bgate, float* LOGF, int tid, int lane, int wave) {
    constexpr int PW = 2 * 1088;
    const int fr = lane & 15, fq = lane >> 4;
#pragma unroll
    for (int rb = 0; rb < 2; ++rb) *(LAS f32x4*)(lds + wave * PW + rb * 1088 + fq * 272 + fr * 16) = acc[rb][0];
    __syncthreads();
    {
        const int r = tid >> 4, q = tid & 15, m = 32 * rt + r;
        f32x4 v = (f32x4){0.f, 0.f, 0.f, 0.f};
        const int off = (r >> 4) * 1088 + (q & 3) * 272 + (r & 15) * 16;
#pragma unroll
        for (int w = 0; w < 8; ++w) v += *(const LAS f32x4*)(lds + w * PW + off);
        v = v * rsqrtf(rowss[m] * (1.f / DM) + EPS) + *(const f32x4*)(biasgr + (size_t)modrow(m) * 64 + 4 * (q & 3));
        float gr[16];
#pragma unroll
        for (int qq = 0; qq < 4; ++qq) { const int src = (lane & 48) + qq;
            gr[4 * qq + 0] = __shfl(v.x, src); gr[4 * qq + 1] = __shfl(v.y, src); gr[4 * qq + 2] = __shfl(v.z, src); gr[4 * qq + 3] = __shfl(v.w, src); }
        const LAS float* wgate = (const LAS float*)(lds + 65536);
        f32x4 pre[4];
#pragma unroll
        for (int i = 0; i < 4; ++i) pre[i] = *(const f32x4*)(bgate + 4 * q + 64 * i);
#pragma unroll
        for (int rr = 0; rr < 16; ++rr)
#pragma unroll
            for (int i = 0; i < 4; ++i) pre[i] += gr[rr] * *(const LAS f32x4*)(wgate + rr * 256 + 4 * q + 64 * i);
#pragma unroll
        for (int i = 0; i < 4; ++i) { f32x4 o;
#pragma unroll
            for (int jj = 0; jj < 4; ++jj) { const float pv = pre[i][jj]; o[jj] = (fminf(pv, 0.f) - __logf(1.f + __expf(-fabsf(pv)))) * (1.f / 16.f); }
            *(f32x4*)(LOGF + (size_t)m * 256 + 4 * q + 64 * i) = o; }
    }
    __syncthreads();
}
__device__ __forceinline__ void gate_gemm(LAS unsigned char* lds, const bf16* Hall, const bf16* WGR, const float* wg, const float* rowss, const float* biasgr, const float* bgate, float* LOGF,
                                          int tid, int lane, int wave, int bid, int G) {
    for (int idx = tid; idx < 1024; idx += 512) *(LAS f32x4*)(lds + 65536 + 16 * idx) = *(const f32x4*)(wg + 4 * idx);
    for (int rnd = 0; rnd < 2; ++rnd) {
        int it, it1; bool two;
        if (G == 256) {
            if (bid < 128) { if (rnd == 0) { it = bid; it1 = 512 + bid; two = bid < 8; } else break; }
            else { const int t0 = 128 + 3 * (bid - 128); if (rnd == 0) { it = t0; it1 = t0 + 1; two = true; } else { it = t0 + 2; it1 = it; two = false; } }
        } else { if (rnd == 1 || bid >= MT / 32) break; it = bid; it1 = bid; two = false; }
        f32x4 acc0[2][1], acc1[2][1];
        if (two) {
            sg_compute<16, DM, false>(acc0, Hall, WGR, it, 0, lane, wave);
            sg_compute<16, DM, false>(acc1, Hall, WGR, it1, 0, lane, wave);
            gate_finish(lds, acc0, it, rowss, biasgr, bgate, LOGF, tid, lane, wave);
            gate_finish(lds, acc1, it1, rowss, biasgr, bgate, LOGF, tid, lane, wave);
        } else {
            sg_compute<16, DM, false>(acc0, Hall, WGR, it, 0, lane, wave);
            gate_finish(lds, acc0, it, rowss, biasgr, bgate, LOGF, tid, lane, wave);
        }
    }
    if (G != 256) for (int it = bid + G; it < MT / 32; it += G) { f32x4 acc0[2][1]; sg_compute<16, DM, false>(acc0, Hall, WGR, it, 0, lane, wave); gate_finish(lds, acc0, it, rowss, biasgr, bgate, LOGF, tid, lane, wave); }
}
#define XB_TMO      128
#define XB_XCNT(j)  (256  + 64 * (j))
#define XB_XSUB(j)  (1280 + 64 * (j))
#define XB_XGEN(j)  (2304 + 64 * (j))
#define XB_TOP      3328
#define XB_TOPGEN   3392
#define XCD_BAR_WORDS 3456
#define XB_SPIN_CAP (1u << 18)

__device__ __forceinline__ unsigned xb_ld(unsigned* p)              { return __hip_atomic_load(p, __ATOMIC_RELAXED, __HIP_MEMORY_SCOPE_AGENT); }
__device__ __forceinline__ unsigned xb_add(unsigned* p, unsigned v) { return __hip_atomic_fetch_add(p, v, __ATOMIC_RELAXED, __HIP_MEMORY_SCOPE_AGENT); }
__device__ __forceinline__ unsigned xb_xcc_id() { return (unsigned)__builtin_amdgcn_s_getreg((3 << 11) | 20) & 0xFu; }
#define XB_SPIN(cond, bar) do { unsigned _sp = 0; while (cond) { __builtin_amdgcn_s_sleep(1); \
    if ((++_sp & 255u) == 0u) { if (xb_ld(&(bar)[XB_TMO])) break; if (_sp > XB_SPIN_CAP) { atomicAdd(&(bar)[XB_TMO], 1u); break; } } } } while (0)

struct XcdBarrier {
    unsigned* bar; unsigned x;
    volatile LAS unsigned* st;
};

__device__ __forceinline__ XcdBarrier xcd_barrier_post(unsigned* bar, volatile LAS unsigned* st) {
    XcdBarrier b; b.bar = bar; b.x = xb_xcc_id(); b.st = st;
    if (threadIdx.x == 0) (void)xb_add(&bar[XB_XCNT(b.x)], 1u);
    return b;
}
__device__ __forceinline__ void xcd_barrier_complete(unsigned* bar, unsigned x, unsigned& nloc, unsigned& nx) {
    const unsigned G = gridDim.x * gridDim.y * gridDim.z;
    unsigned sum, cnt, mine, sp = 0u;
    for (;;) {
        sum = 0u; cnt = 0u; mine = 0u;
#pragma unroll
        for (unsigned j = 0; j < 16; ++j) { const unsigned c = xb_ld(&bar[XB_XCNT(j)]); sum += c; cnt += (c > 0u) ? 1u : 0u; mine = (j == x) ? c : mine; }
        if (sum == G) break;
        __builtin_amdgcn_s_sleep(1);
        if ((++sp & 255u) == 0u) { if (xb_ld(&bar[XB_TMO])) break; if (sp > XB_SPIN_CAP) { atomicAdd(&bar[XB_TMO], 1u); break; } }
    }
    nloc = mine > 0u ? mine : 1u; nx = cnt > 0u ? cnt : 1u;
}

__device__ __forceinline__ void xcd_barrier(const XcdBarrier& b) {
    asm volatile("s_waitcnt vmcnt(0)" ::: "memory");
    __syncthreads();
    if (threadIdx.x == 0) {
        unsigned* bar = b.bar; unsigned bx_ = b.x; asm volatile("" : "+v"(bar), "+v"(bx_));
        __builtin_amdgcn_s_waitcnt(0);
        unsigned nloc = b.st[0], nx = b.st[1];
        if (nloc == 0u) { xcd_barrier_complete(bar, bx_, nloc, nx); b.st[0] = nloc; b.st[1] = nx; }
        const unsigned old = xb_add(&bar[XB_XSUB(bx_)], 1u);
        const unsigned gen = old / nloc;
        if (old + 1u == (gen + 1u) * nloc) {
            __builtin_amdgcn_fence(__ATOMIC_RELEASE, "agent");
            asm volatile("s_waitcnt vmcnt(0)" ::: "memory");
            const unsigned og = xb_add(&bar[XB_TOP], 1u);
            const unsigned tg = og / nx;
            if (og + 1u == (tg + 1u) * nx) xb_add(&bar[XB_TOPGEN], 1u);
            else XB_SPIN(xb_ld(&bar[XB_TOPGEN]) == tg, bar);
            __builtin_amdgcn_fence(__ATOMIC_ACQUIRE, "agent");
            xb_add(&bar[XB_XGEN(bx_)], 1u);
            asm volatile("s_waitcnt vmcnt(0)" ::: "memory");
        } else {
            XB_SPIN(xb_ld(&bar[XB_XGEN(bx_)]) == gen, bar);
            __builtin_amdgcn_fence(__ATOMIC_ACQUIRE, "agent");
            asm volatile("s_waitcnt vmcnt(0)" ::: "memory");
        }
    }
    __syncthreads();
}


__device__ __forceinline__ void attn_unit(LAS unsigned char* lds, const bf16* Qp, int nact, int qpos0, const float* kA, const float* vA, const float* kB, const float* vB,
                                          int split, int nkeys, bf16* Op, int tid, int lane, int wave) {
    const int fr = lane & 15, fq = lane >> 4;
    const bool wact0 = wave < nact;
    bf16x8 qf0 = {0, 0, 0, 0, 0, 0, 0, 0}, qf1 = qf0;
    if (wact0) { const bf16* qr = Qp + (size_t)(16 * wave + fr) * 512 + 8 * fq; qf0 = *(const bf16x8*)qr; qf1 = *(const bf16x8*)(qr + 32); }
    const int qpos = qpos0 + 16 * wave + fr, qmaxw = qpos0 + 16 * wave + 15;
    float R = 0.f;
    f32x4 o[4];
#pragma unroll
    for (int i = 0; i < 4; ++i) o[i] = (f32x4){0.f, 0.f, 0.f, 0.f};
    bool wact = wact0;
    unsigned tri0, tri1;
    { const unsigned b0 = (4 * fq + 0 >= fr) ? 0x3F80u : 0u, b1 = (4 * fq + 1 >= fr) ? 0x3F80u : 0u, b2 = (4 * fq + 2 >= fr) ? 0x3F80u : 0u, b3 = (4 * fq + 3 >= fr) ? 0x3F80u : 0u;
      tri0 = b0 | (b1 << 16); tri1 = b2 | (b3 << 16); }
    const unsigned ONE2 = 0x3F803F80u;
    const bf16x8 TA = __builtin_bit_cast(bf16x8, (u32x4){tri0, tri1, ONE2, ONE2});
    const bf16x8 TB = __builtin_bit_cast(bf16x8, (u32x4){ONE2, ONE2, ONE2, ONE2});
    const bf16x8 TC = __builtin_bit_cast(bf16x8, (u32x4){0u, 0u, tri0, tri1});
    volatile LAS int* flags = (volatile LAS int*)(lds + 36864);
    int cur = 0;
    const int key = tid >> 3, d0 = (tid & 7) * 8;
    int jt = (qpos0 + 16 * nact - 2) >> 6;
    f32x4 pk0, pk1, pv0, pv1;
#define ATT_LOAD(JT) do { const int kap_ = 64 * (JT) + key; \
        if (kap_ < nkeys) { const float* kp_ = (kap_ < split ? kA + (size_t)kap_ * 512 : kB + (size_t)(kap_ - split) * 512) + d0; \
                            const float* vp_ = (kap_ < split ? vA + (size_t)kap_ * 512 : vB + (size_t)(kap_ - split) * 512) + d0; \
                            pk0 = *(const f32x4*)kp_; pk1 = *(const f32x4*)(kp_ + 4); pv0 = *(const f32x4*)vp_; pv1 = *(const f32x4*)(vp_ + 4); } \
        else { pk0 = pk1 = pv0 = pv1 = (f32x4){0.f, 0.f, 0.f, 0.f}; } } while (0)
#define ATT_WRITE(BUF) do { LAS unsigned char* Kw_ = lds + (BUF) * 18432; \
          u32x4 kw; kw.x = pk2(pk0.x, pk0.y); kw.y = pk2(pk0.z, pk0.w); kw.z = pk2(pk1.x, pk1.y); kw.w = pk2(pk1.z, pk1.w); \
          *(LAS u32x4*)(Kw_ + key * 144 + d0 * 2) = kw; \
            \
          u32x4 vw; vw.x = pk2(pv0.x, pv0.y); vw.y = pk2(pv0.z, pv0.w); vw.z = pk2(pv1.x, pv1.y); vw.w = pk2(pv1.z, pv1.w); \
          *(LAS u32x4*)(Kw_ + 9216 + key * 144 + d0 * 2) = vw; } while (0)
    ATT_LOAD(jt);
    ATT_WRITE(0);
    __syncthreads();
    for (;;) {
        LAS unsigned char* Ks = lds + cur * 18432; LAS unsigned char* VT = Ks + 9216;
        if (jt > 0) ATT_LOAD(jt - 1);
        if (wact && 64 * jt < qmaxw) {
            f32x4 s[4];
            __builtin_amdgcn_s_setprio(1);
#pragma unroll
            for (int n = 0; n < 4; ++n) {
                const LAS unsigned char* kp = Ks + (16 * n + fr) * 144 + 16 * fq;
                const bf16x8 ka = *(const LAS bf16x8*)kp, kb = *(const LAS bf16x8*)(kp + 64);
                s[n] = MFMA16(ka, qf0, ((f32x4){0.f, 0.f, 0.f, 0.f}));
                s[n] = MFMA16(kb, qf1, s[n]);
            }
            __builtin_amdgcn_s_setprio(0);
            const int kbase = 64 * jt + 4 * fq;
            const bool full = 64 * jt + 64 <= qpos0 + 16 * wave;
            f32x4 l2[4];
#pragma unroll
            for (int n = 0; n < 4; ++n)
#pragma unroll
                for (int j = 0; j < 4; ++j) { const bool valid = full || (kbase + 16 * n + j) < qpos; const float e = __builtin_amdgcn_exp2f(s[n][j]); const float lg = -__builtin_amdgcn_logf(1.f + e); l2[n][j] = valid ? lg : 0.f; }
            const bf16x8 lb0 = pack8(l2[0], l2[1]), lb1 = pack8(l2[2], l2[3]);
            const f32x4 z4 = (f32x4){0.f, 0.f, 0.f, 0.f};
            f32x4 suf[4];
            __builtin_amdgcn_s_setprio(1);
            suf[0] = MFMA16(TA, lb0, z4); suf[0] = MFMA16(TB, lb1, suf[0]);
            suf[1] = MFMA16(TC, lb0, z4); suf[1] = MFMA16(TB, lb1, suf[1]);
            suf[2] = MFMA16(TA, lb1, z4);
            suf[3] = MFMA16(TC, lb1, z4);
            __builtin_amdgcn_s_setprio(0);
            const float tot = __shfl(suf[0][0], fr);
            f32x4 p[4];
#pragma unroll
            for (int n = 0; n < 4; ++n)
#pragma unroll
                for (int j = 0; j < 4; ++j) { const bool valid = full || (kbase + 16 * n + j) < qpos; const float w = __builtin_amdgcn_exp2f(s[n][j] + suf[n][j] + R); p[n][j] = valid ? w : 0.f; }
            R += tot;
            const bf16x8 pb0 = pack8(p[0], p[1]), pb1 = pack8(p[2], p[3]);
            __builtin_amdgcn_s_setprio(1);
#pragma unroll
            for (int db = 0; db < 4; ++db) {
                const LAS unsigned char* vp = VT + (4 * fq + (fr >> 2)) * 144 + 32 * db + 8 * (fr & 3);
                typedef short v4i16_t __attribute__((ext_vector_type(4)));
                const v4i16_t t0 = __builtin_amdgcn_ds_read_tr16_b64_v4i16((LAS v4i16_t*)(vp)),             t1 = __builtin_amdgcn_ds_read_tr16_b64_v4i16((LAS v4i16_t*)(vp + 16 * 144)),
                              t2 = __builtin_amdgcn_ds_read_tr16_b64_v4i16((LAS v4i16_t*)(vp + 32 * 144)), t3 = __builtin_amdgcn_ds_read_tr16_b64_v4i16((LAS v4i16_t*)(vp + 48 * 144));
                const bf16x8 va0 = {t0[0], t0[1], t0[2], t0[3], t1[0], t1[1], t1[2], t1[3]}, va1 = {t2[0], t2[1], t2[2], t2[3], t3[0], t3[1], t3[2], t3[3]};
                o[db] = MFMA16(va0, pb0, o[db]); o[db] = MFMA16(va1, pb1, o[db]);
            }
            __builtin_amdgcn_s_setprio(0);
            wact = __any(R > -150.f);
        }
        if (jt > 0) ATT_WRITE(cur ^ 1);
        if (lane == 0) flags[(jt & 1) * 8 + wave] = wact ? 1 : 0;
        __syncthreads();
        if (jt == 0) break;
        int any = 0;
#pragma unroll
        for (int w = 0; w < 8; ++w) any |= flags[(jt & 1) * 8 + w];
        if (!any) break;
        --jt; cur ^= 1;
    }
#undef ATT_LOAD
#undef ATT_WRITE
    if (wact0) {
        bf16* op = Op + (size_t)(16 * wave + fr) * 1024 + 4 * fq;
#pragma unroll
        for (int db = 0; db < 4; ++db) { u32x2 w; w.x = pk2(o[db].x, o[db].y); w.y = pk2(o[db].z, o[db].w); *(u32x2*)(op + 16 * db) = w; }
    }
    __syncthreads();
}

__device__ __forceinline__ void gla_a_unit(const Args& a, LAS unsigned char* lds, int b, int c, int hh, int tid, int lane, int wave) {
    const float* LOGF = (const float*)(a.ws + WS_LOGF); const bf16* KG = (const bf16*)(a.ws + WS_KG); const bf16* VG = (const bf16*)(a.ws + WS_VG);
    float* U = (float*)(a.ws + WS_U); float* ACH = (float*)(a.ws + WS_ACH);
    const int m0 = b * 8192 + 64 * c, unit = (b * 128 + c) * 4 + hh;
    LAS float* gsum = (LAS float*)lds;
    LAS unsigned char* kT = lds + 2048;
    LAS unsigned char* vT = lds + 11264;
    const int d = tid & 63, g = tid >> 6;
    float lf[8];
#pragma unroll
    for (int i = 0; i < 8; ++i) lf[i] = LOGF[(size_t)(m0 + 8 * g + i) * 256 + hh * 64 + d];
    unsigned short kraw[8];
#pragma unroll
    for (int i = 0; i < 8; ++i) kraw[i] = KG[(size_t)(m0 + 8 * g + i) * 256 + hh * 64 + d];
    float es[8]; float run = 0.f;
#pragma unroll
    for (int i = 7; i >= 0; --i) { es[i] = run; run += lf[i]; }
    gsum[g * 64 + d] = run;
    { const int s = tid >> 4, c8 = (tid & 15) * 8;
      const u32x4 r0 = *(const u32x4*)(VG + (size_t)(m0 + s) * 512 + hh * 128 + c8), r1 = *(const u32x4*)(VG + (size_t)(m0 + s + 32) * 512 + hh * 128 + c8);
      *(LAS u32x4*)(vT + s * 272 + c8 * 2) = r0; *(LAS u32x4*)(vT + (s + 32) * 272 + c8 * 2) = r1; }
    __syncthreads();
    float later = 0.f, total = 0.f;
#pragma unroll
    for (int gg = 0; gg < 8; ++gg) { const float t = gsum[gg * 64 + d]; total += t; later += (gg > g) ? t : 0.f; }
    if (g == 0) ACH[(size_t)unit * 64 + d] = __expf(total);
    { float kk[8];
#pragma unroll
      for (int i = 0; i < 8; ++i) kk[i] = bf2f(kraw[i]) * __expf(es[i] + later);
      u32x4 w; w.x = pk2(kk[0], kk[1]); w.y = pk2(kk[2], kk[3]); w.z = pk2(kk[4], kk[5]); w.w = pk2(kk[6], kk[7]);
      *(LAS u32x4*)(kT + d * 144 + g * 16) = w; }
    __syncthreads();
    const int fr = lane & 15, fq = lane >> 4;
    typedef short v4i16_t __attribute__((ext_vector_type(4)));
    bf16x8 va0, va1;
    { const LAS unsigned char* vp = vT + (8 * fq + (fr >> 2)) * 272 + (16 * wave + 4 * (fr & 3)) * 2;
      const v4i16_t t0 = __builtin_amdgcn_ds_read_tr16_b64_v4i16((LAS v4i16_t*)(vp)), t1 = __builtin_amdgcn_ds_read_tr16_b64_v4i16((LAS v4i16_t*)(vp + 4 * 272)),
                    t2 = __builtin_amdgcn_ds_read_tr16_b64_v4i16((LAS v4i16_t*)(vp + 32 * 272)), t3 = __builtin_amdgcn_ds_read_tr16_b64_v4i16((LAS v4i16_t*)(vp + 36 * 272));
      va0 = (bf16x8){t0[0], t0[1], t0[2], t0[3], t1[0], t1[1], t1[2], t1[3]}; va1 = (bf16x8){t2[0], t2[1], t2[2], t2[3], t3[0], t3[1], t3[2], t3[3]}; }
    float* up = U + (size_t)unit * 8192 + (size_t)(16 * wave + 4 * fq) * 64 + fr;
#pragma unroll
    for (int db = 0; db < 4; ++db) {
        const bf16x8 kb0 = *(const LAS bf16x8*)(kT + (16 * db + fr) * 144 + 16 * fq), kb1 = *(const LAS bf16x8*)(kT + (16 * db + fr) * 144 + 64 + 16 * fq);
        f32x4 acc = MFMA16(va0, kb0, ((f32x4){0.f, 0.f, 0.f, 0.f})); acc = MFMA16(va1, kb1, acc);
        up[16 * db] = acc.x; up[16 * db + 64] = acc.y; up[16 * db + 128] = acc.z; up[16 * db + 192] = acc.w;
    }
    __syncthreads();
}

__device__ __forceinline__ void gla_scan(const Args& a, LAS unsigned char* lds, int l, int tid, int lane, int wave, int bid, int G) {
    const float* __restrict__ U = (const float*)(a.ws + WS_U); float* __restrict__ S = (float*)(a.ws + WS_S); const float* __restrict__ ACH = (const float*)(a.ws + WS_ACH);
    float* __restrict__ outp = a.out;
    LAS f32x4* cP = (LAS f32x4*)lds;
    LAS f32x4* cS = (LAS f32x4*)(lds + 8192);
    for (int it = bid; it < 256; it += G) {
        const int bh = it >> 5, b = bh >> 2, hh = bh & 3, e = (it & 31) * 256 + 4 * lane, d = e & 63, v = e >> 6;
        f32x4 u[16], p[16];
#pragma unroll
        for (int i = 0; i < 16; ++i) { const size_t unit = (size_t)(b * 128 + 16 * wave + i) * 4 + hh; u[i] = *(const f32x4*)(U + unit * 8192 + e); p[i] = *(const f32x4*)(ACH + unit * 64 + d); }
        f32x4 s = (f32x4){0.f, 0.f, 0.f, 0.f}, pr = (f32x4){1.f, 1.f, 1.f, 1.f};
#pragma unroll
        for (int i = 0; i < 16; ++i) { s = p[i] * s + u[i]; pr = pr * p[i]; u[i] = s; p[i] = pr; }
        cP[wave * 64 + lane] = pr; cS[wave * 64 + lane] = s;
        __syncthreads();
        f32x4 carry = (f32x4){0.f, 0.f, 0.f, 0.f};
        for (int w = 0; w < wave; ++w) carry = cP[w * 64 + lane] * carry + cS[w * 64 + lane];
#pragma unroll
        for (int i = 0; i < 16; ++i) { const size_t unit = (size_t)(b * 128 + 16 * wave + i) * 4 + hh; u[i] = u[i] + p[i] * carry; *(f32x4*)(S + unit * 8192 + e) = u[i]; }
        if (wave == 7) { float* op = outp + OUT_SP + ((size_t)(l * 2 + b) * 4 + hh) * 8192 + v;
            op[(d + 0) * 128] = u[15].x; op[(d + 1) * 128] = u[15].y; op[(d + 2) * 128] = u[15].z; op[(d + 3) * 128] = u[15].w; }
        __syncthreads();
    }
}

__device__ __forceinline__ void gla_c_unit(const Args& a, LAS unsigned char* lds, int l, int b, int c, int hh, int tid, int lane, int wave) {
    const float* LOGF = (const float*)(a.ws + WS_LOGF); const bf16* QG = (const bf16*)(a.ws + WS_QG); const bf16* KG = (const bf16*)(a.ws + WS_KG);
    const bf16* VG = (const bf16*)(a.ws + WS_VG); const bf16* OG = (const bf16*)(a.ws + WS_OG); const float* U = (const float*)(a.ws + WS_S);
    bf16* MERGED = (bf16*)(a.ws + WS_MERGED); const float* gn = a.in[16] + l * 128;
    const int m0 = b * 8192 + 64 * c, unit = (b * 128 + c) * 4 + hh;
    LAS float* gsum = (LAS float*)lds;
    LAS float* Btab = (LAS float*)(lds + 2048);
    LAS unsigned char* Qs = lds + 18432;
    LAS unsigned char* Ks = lds + 27648;
    LAS unsigned char* vT = lds + 36864;
    LAS float* part = (LAS float*)(lds + 55296);
    const int fr = lane & 15, fq = lane >> 4;
    const int tb = wave & 3, vh = wave >> 2;
    const int d_ = tid & 63, g_ = tid >> 6;
    float lf[8];
#pragma unroll
    for (int i = 0; i < 8; ++i) lf[i] = LOGF[(size_t)(m0 + 8 * g_ + i) * 256 + hh * 64 + d_];
    const int vs_ = tid >> 4, vc8_ = (tid & 15) * 8;
    const u32x4 vr0 = *(const u32x4*)(VG + (size_t)(m0 + vs_) * 512 + hh * 128 + vc8_), vr1 = *(const u32x4*)(VG + (size_t)(m0 + vs_ + 32) * 512 + hh * 128 + vc8_);
    const int t_ = tid >> 3, d0_ = (tid & 7) * 8;
    const u32x4 qw = *(const u32x4*)(QG + (size_t)(m0 + t_) * 256 + hh * 64 + d0_), kw = *(const u32x4*)(KG + (size_t)(m0 + t_) * 256 + hh * 64 + d0_);
    f32x4 sfr[4][4];
    if (c > 0) {
#pragma unroll
        for (int i = 0; i < 4; ++i) { const float* sp = U + (size_t)(unit - 4) * 8192 + (size_t)(16 * (4 * vh + i) + fr) * 64 + 8 * fq;
            sfr[i][0] = *(const f32x4*)sp; sfr[i][1] = *(const f32x4*)(sp + 4); sfr[i][2] = *(const f32x4*)(sp + 32); sfr[i][3] = *(const f32x4*)(sp + 36); }
    }
    const int m = m0 + 16 * tb + fr;
    u32x2 ogw[4]; f32x4 gnv[4];
#pragma unroll
    for (int i = 0; i < 4; ++i) { const int v0 = 16 * (4 * vh + i) + 4 * fq; ogw[i] = *(const u32x2*)(OG + (size_t)m * 512 + hh * 128 + v0); gnv[i] = *(const f32x4*)(gn + v0); }
    { float run = 0.f;
#pragma unroll
      for (int i = 0; i < 8; ++i) { run += lf[i]; lf[i] = run; }
      gsum[g_ * 64 + d_] = run;
      *(LAS u32x4*)(vT + vs_ * 272 + vc8_ * 2) = vr0; *(LAS u32x4*)(vT + (vs_ + 32) * 272 + vc8_ * 2) = vr1;
      __syncthreads();
      float earlier = 0.f;
#pragma unroll
      for (int gg = 0; gg < 8; ++gg) earlier += (gg < g_) ? gsum[gg * 64 + d_] : 0.f;
#pragma unroll
      for (int i = 0; i < 8; ++i) Btab[(8 * g_ + i) * 64 + d_] = lf[i] + earlier;
    }
    __syncthreads();
    { const int t = t_, d0 = d0_;
      const f32x4 b0 = *(const LAS f32x4*)(Btab + t * 64 + d0), b1 = *(const LAS f32x4*)(Btab + t * 64 + d0 + 4);
      float eb[8] = {__expf(b0.x), __expf(b0.y), __expf(b0.z), __expf(b0.w), __expf(b1.x), __expf(b1.y), __expf(b1.z), __expf(b1.w)};
      float ib[8] = {__expf(-b0.x), __expf(-b0.y), __expf(-b0.z), __expf(-b0.w), __expf(-b1.x), __expf(-b1.y), __expf(-b1.z), __expf(-b1.w)};
      u32x4 qo, ko;
      qo.x = pk2(bflo(qw.x) * eb[0], bfhi(qw.x) * eb[1]); qo.y = pk2(bflo(qw.y) * eb[2], bfhi(qw.y) * eb[3]); qo.z = pk2(bflo(qw.z) * eb[4], bfhi(qw.z) * eb[5]); qo.w = pk2(bflo(qw.w) * eb[6], bfhi(qw.w) * eb[7]);
      ko.x = pk2(bflo(kw.x) * ib[0], bfhi(kw.x) * ib[1]); ko.y = pk2(bflo(kw.y) * ib[2], bfhi(kw.y) * ib[3]); ko.z = pk2(bflo(kw.z) * ib[4], bfhi(kw.z) * ib[5]); ko.w = pk2(bflo(kw.w) * ib[6], bfhi(kw.w) * ib[7]);
      *(LAS u32x4*)(Qs + t * 144 + d0 * 2) = qo; *(LAS u32x4*)(Ks + t * 144 + d0 * 2) = ko; }
    __syncthreads();
    const bf16x8 qb0 = *(const LAS bf16x8*)(Qs + (16 * tb + fr) * 144 + 16 * fq), qb1 = *(const LAS bf16x8*)(Qs + (16 * tb + fr) * 144 + 64 + 16 * fq);
    const f32x4 z4 = (f32x4){0.f, 0.f, 0.f, 0.f};
    f32x4 at[4];
#pragma unroll
    for (int sb = 0; sb < 4; ++sb) {
        at[sb] = z4;
        if (sb <= tb) {
            const bf16x8 k0 = *(const LAS bf16x8*)(Ks + (16 * sb + fr) * 144 + 16 * fq), k1 = *(const LAS bf16x8*)(Ks + (16 * sb + fr) * 144 + 64 + 16 * fq);
            f32x4 t = MFMA16(k0, qb0, z4); t = MFMA16(k1, qb1, t);
            if (sb == tb) {
#pragma unroll
                for (int j = 0; j < 4; ++j) t[j] = (4 * fq + j <= fr) ? t[j] : 0.f;
            }
            at[sb] = t;
        }
    }
    const bf16x8 ab0 = pack8(at[0], at[1]), ab1 = pack8(at[2], at[3]);
    f32x4 o[4];
#pragma unroll
    for (int i = 0; i < 4; ++i) {
        const int vb = 4 * vh + i;
        typedef short v4i16_t __attribute__((ext_vector_type(4)));
        const LAS unsigned char* vp = vT + (4 * fq + (fr >> 2)) * 272 + (16 * vb + 4 * (fr & 3)) * 2;
        const v4i16_t t0 = __builtin_amdgcn_ds_read_tr16_b64_v4i16((LAS v4i16_t*)(vp)), t1 = __builtin_amdgcn_ds_read_tr16_b64_v4i16((LAS v4i16_t*)(vp + 16 * 272));
        f32x4 acc = MFMA16(((bf16x8){t0[0], t0[1], t0[2], t0[3], t1[0], t1[1], t1[2], t1[3]}), ab0, z4);
        if (tb >= 2) { const v4i16_t t2 = __builtin_amdgcn_ds_read_tr16_b64_v4i16((LAS v4i16_t*)(vp + 32 * 272)), t3 = __builtin_amdgcn_ds_read_tr16_b64_v4i16((LAS v4i16_t*)(vp + 48 * 272));
                       acc = MFMA16(((bf16x8){t2[0], t2[1], t2[2], t2[3], t3[0], t3[1], t3[2], t3[3]}), ab1, acc); }
        if (c > 0) { acc = MFMA16(pack8(sfr[i][0], sfr[i][1]), qb0, acc); acc = MFMA16(pack8(sfr[i][2], sfr[i][3]), qb1, acc); }
        o[i] = acc;
    }
    float ss = 0.f;
#pragma unroll
    for (int i = 0; i < 4; ++i) ss += (o[i].x * o[i].x + o[i].y * o[i].y) + (o[i].z * o[i].z + o[i].w * o[i].w);
    ss += __shfl_xor(ss, 16); ss += __shfl_xor(ss, 32);
    if (fq == 0) part[wave * 16 + fr] = ss;
    __syncthreads();
    const float tot = part[wave * 16 + fr] + part[(wave ^ 4) * 16 + fr];
    const float rstd = rsqrtf(tot * (1.f / 128.f) + EPS);
#pragma unroll
    for (int i = 0; i < 4; ++i) {
        const int v0 = 16 * (4 * vh + i) + 4 * fq;
        const f32x4 g = gnv[i];
        const float r0 = o[i].x * rstd * g.x * silu_f(bflo(ogw[i].x)), r1 = o[i].y * rstd * g.y * silu_f(bfhi(ogw[i].x));
        const float r2 = o[i].z * rstd * g.z * silu_f(bflo(ogw[i].y)), r3 = o[i].w * rstd * g.w * silu_f(bfhi(ogw[i].y));
        u32x2 w; w.x = pk2(r0, r1); w.y = pk2(r2, r3);
        *(u32x2*)(MERGED + (size_t)m * 1024 + 512 + hh * 128 + v0) = w;
    }
    __syncthreads();
}

__device__ __forceinline__ void gla_sample_unit(const Args& a, LAS unsigned char* lds, int l, int b, int hh, int part, int tid) {
    const float* LOGF = (const float*)(a.ws + WS_LOGF); const bf16* QG = (const bf16*)(a.ws + WS_QG); const bf16* KG = (const bf16*)(a.ws + WS_KG);
    const bf16* VG = (const bf16*)(a.ws + WS_VG); const bf16* OG = (const bf16*)(a.ws + WS_OG);
    bf16* MERGED = (bf16*)(a.ws + WS_MERGED); const float* gn = a.in[16] + l * 128;
    const float* S0g = a.in[6] + ((size_t)(l * 16 + b) * 4 + hh) * 8192;
    float* Sout = a.out + OUT_SS + ((size_t)(l * 16 + b) * 4 + hh) * 8192;
    const int m0 = TP + 16 * b;
    LAS float* S0 = (LAS float*)lds;
    LAS float* qp = (LAS float*)(lds + 32768);
    LAS float* kpp = qp + 1024;
    LAS float* kl = kpp + 1024;
    LAS float* vv = kl + 1024;
    LAS float* att = vv + 2048;
    LAS float* exl = att + 64;
    LAS float* pss = exl + 64;
#pragma unroll 4
    for (int i = tid; i < 2048; i += 512) *(LAS f32x4*)(S0 + 4 * i) = *(const f32x4*)(S0g + 4 * i);
#pragma unroll 2
    for (int i = tid; i < 2048; i += 512) { const int t = i >> 7, v = i & 127; vv[i] = bf2f(VG[(size_t)(m0 + t) * 512 + hh * 128 + v]); }
    if (tid < 64) {
        const int d = tid; float bb[16]; float run = 0.f;
#pragma unroll
        for (int t = 0; t < 16; ++t) { run += LOGF[(size_t)(m0 + t) * 256 + hh * 64 + d]; bb[t] = run; }
        exl[d] = __expf(run);
#pragma unroll
        for (int t = 0; t < 16; ++t) {
            const float q = bf2f(QG[(size_t)(m0 + t) * 256 + hh * 64 + d]), k = bf2f(KG[(size_t)(m0 + t) * 256 + hh * 64 + d]);
            qp[t * 64 + d] = q * __expf(bb[t]); kpp[t * 64 + d] = k * __expf(-bb[t]); kl[t * 64 + d] = k * __expf(run - bb[t]);
        }
    }
    __syncthreads();
    if (tid < 64) { const int t = 4 * part + (tid >> 4), s = tid & 15; float acc = 0.f;
        if (s <= t) {
#pragma unroll 4
            for (int d = 0; d < 64; ++d) acc += qp[t * 64 + d] * kpp[s * 64 + d]; }
        att[tid] = acc; }
    __syncthreads();
    const int v = tid & 127, ti = tid >> 7, t = 4 * part + ti;
    float o1 = 0.f;
#pragma unroll 4
    for (int s = 0; s < 16; ++s) o1 += att[ti * 16 + s] * vv[s * 128 + v];
#pragma unroll 4
    for (int d = 0; d < 64; ++d) o1 += qp[t * 64 + d] * S0[d * 128 + v];
    { const float sq = wave_sum(o1 * o1); if ((tid & 63) == 0) pss[ti * 2 + ((tid >> 6) & 1)] = sq; }
#pragma unroll
    for (int i = 0; i < 4; ++i) { const int d = 16 * part + 4 * ti + i; float acc = exl[d] * S0[d * 128 + v];
#pragma unroll 4
        for (int s = 0; s < 16; ++s) acc += kl[s * 64 + d] * vv[s * 128 + v];
        Sout[d * 128 + v] = acc; }
    __syncthreads();
    { const float tot = pss[ti * 2] + pss[ti * 2 + 1];
      const float rstd = rsqrtf(tot * (1.f / 128.f) + EPS);
      const float og = bf2f(OG[(size_t)(m0 + t) * 512 + hh * 128 + v]);
      MERGED[(size_t)(m0 + t) * 1024 + 512 + hh * 128 + v] = (bf16)f2bf(o1 * rstd * gn[v] * silu_f(og)); }
    __syncthreads();
}

#ifndef REP_PRO
#define REP_PRO 1
#endif
#ifndef REP_NORM0
#define REP_NORM0 1
#endif
#ifndef REP_NORM1
#define REP_NORM1 1
#endif
#ifndef REP_MIX
#define REP_MIX 1
#endif
#ifndef REP_GLAS
#define REP_GLAS 1
#endif
#ifndef REP_GLAC
#define REP_GLAC 1
#endif
#ifndef REP_GIN
#define REP_GIN 1
#endif
#ifndef REP_GUP
#define REP_GUP 1
#endif
#ifndef USE_QUEUE
#define USE_QUEUE 1
#endif
#ifndef REP_GOUT
#define REP_GOUT 1
#endif
#ifndef REP_GDN
#define REP_GDN 1
#endif
#ifndef REP_SCAN
#define REP_SCAN 1
#endif
#ifndef REP_SG
#define REP_SG 1
#endif
__global__ void __launch_bounds__(512) mk_fwd(Args a) {
    extern __shared__ __attribute__((aligned(16))) unsigned char lds_raw[];
    LAS unsigned char* lds = (LAS unsigned char*)lds_raw;
    cg::grid_group grid = cg::this_grid();
    const int G = gridDim.x, bid = blockIdx.x;
#ifndef REP_BAR
#define REP_BAR 1
#endif
#define GRID_BAR() do { for (int rb_ = 0; rb_ < REP_BAR; ++rb_) xcd_barrier(bar); } while (0)
#define FRESH() int tid, lane, wave; { int t_ = threadIdx.x; asm volatile("" : "+v"(t_)); tid = t_; lane = t_ & 63; wave = __builtin_amdgcn_readfirstlane(t_ >> 6); }
#define FRESH_WS() unsigned char* ws_ = a.ws; asm volatile("" : "+s"(ws_))
#define LDP(i) ((const float*)ld_ptr(lds + ARGS_OFF + 8 * (i)))
#define FRESH_ARGS() Args a; { a.in[0] = LDP(0); a.in[1] = LDP(1); a.in[2] = LDP(2); a.in[3] = LDP(3); a.in[4] = LDP(4); a.in[5] = LDP(5); a.in[6] = LDP(6); a.in[7] = LDP(7); a.in[8] = LDP(8); a.in[9] = LDP(9); \
    a.in[10] = LDP(10); a.in[11] = LDP(11); a.in[12] = LDP(12); a.in[13] = LDP(13); a.in[14] = LDP(14); a.in[15] = LDP(15); a.in[16] = LDP(16); a.in[17] = LDP(17); a.in[18] = LDP(18); a.in[19] = LDP(19); \
    a.out = (float*)LDP(20); a.ws = (unsigned char*)LDP(21); a.never = 0; a.pad = 0; }
#define WIN ((bf16*)(a.ws + WS_WIN))
#define WOUT ((bf16*)(a.ws + WS_WOUT))
#define WUP ((bf16*)(a.ws + WS_WUP))
#define WDN ((bf16*)(a.ws + WS_WDN))
#define H ((bf16*)(a.ws + WS_H))
#define Q ((bf16*)(a.ws + WS_Q))
#define MERGED ((bf16*)(a.ws + WS_MERGED))
#define UU ((bf16*)(a.ws + WS_UU))
#define mod ((const float*)(a.ws + WS_MOD))
#define X (a.out)
#define XP (l == 0 ? a.in[0] : X)
#define XS (l == 0 ? a.in[1] : X + (size_t)TP * DM)
    for (int u = threadIdx.x; u < (LDS_BYTES - 131072) / 4; u += 512) ((LAS unsigned*)(lds + 131072))[u] = 0u;
    __syncthreads();
    XcdBarrier bar = xcd_barrier_post((unsigned*)(a.ws + WS_CTL) + 4096, (volatile LAS unsigned*)(lds + 131072 + 320 + 32));

#ifndef NO_PRO
    for (int rep_ = 0; rep_ < REP_PRO; ++rep_, __syncthreads()) { FRESH(); phase_prologue(a, lds, tid, lane, wave, G, bid); }
#endif
    if (a.never) grid.sync();
    GRID_BAR();
    for (int l = 0; l < 2; ++l) {
        if (l == 0) { { FRESH(); prep_phase(a, lds, tid, lane, wave, G, bid); } GRID_BAR(); }
        {
            pg8::Gemm g{H, WIN + (size_t)l * NING * DM, TP, NING, DM}; pg8::StaticOrder S; S.init(TP, NING, G, bid);
            EpiIn E{l, a.out, Q, (bf16*)(a.ws + WS_QG), (bf16*)(a.ws + WS_KG), (bf16*)(a.ws + WS_VG), (bf16*)(a.ws + WS_OG), a.in[12] + l * 64, a.in[13] + l * 64,
                    (const float*)(a.ws + WS_ROWSS_IN) + (size_t)l * MT, (const float*)(a.ws + WS_BIASIN) + (size_t)l * NROWS * NING};
            { SIn SE{l, a.out, Q, (bf16*)(a.ws + WS_QG), (bf16*)(a.ws + WS_KG), (bf16*)(a.ws + WS_VG), (bf16*)(a.ws + WS_OG), a.in[12] + l * 64, a.in[13] + l * 64,
                     (const float*)(a.ws + WS_ROWSS_IN) + (size_t)l * MT, (const float*)(a.ws + WS_BIASIN) + (size_t)l * NROWS * NING};
              for (int step = 0; step < 2; ++step) {
                  if ((step == 0) == ((bid & 1) == 0)) {
                      { FRESH(); gate_gemm(lds, H, (const bf16*)(a.ws + WS_WGR) + (size_t)l * 32 * DM, a.in[14] + l * 16 * 256, (const float*)(a.ws + WS_ROWSS_IN) + (size_t)l * MT,
                                           (const float*)(a.ws + WS_BIASGR) + (size_t)l * NROWS * 64, a.in[15] + l * 256, (float*)(a.ws + WS_LOGF), tid, lane, wave, bid, G); }
                      { FRESH(); small_gemm<64, DM, true, SIn>(lds, H + (size_t)TP * DM, WIN + (size_t)l * NING * DM, 8 * 48, SE, tid, lane, wave, bid, G); }
                  } else { pg8::gemm_phase<EpiIn, pg8::StaticOrder, true, true>(lds, g, S, E); __syncthreads(); }
              } }
        }
        GRID_BAR();
#ifndef NO_MIX
        {
            const int nq = (G % 8 == 0) ? 8 : 1, per = 2432 / nq;
            volatile LAS int* qslot = (volatile LAS int*)(lds + 131072 + 512);
            for (int hop = 0; hop < nq; ++hop) {
                const int x = (bid + hop) % nq;
                unsigned* qctr; { FRESH_WS(); qctr = (unsigned*)(ws_ + WS_CTL) + 64 * (16 + 8 * l + x); }
                int nxt = 0;
                if (threadIdx.x == 0) nxt = (int)atomicAdd(qctr, 1u);
                for (;;) {
                    if (threadIdx.x == 0) *qslot = nxt;
                    __syncthreads();
                    const int j = *qslot;
                    __syncthreads();
                    if (j >= per) break;
                    if (threadIdx.x == 0) nxt = (int)atomicAdd(qctr, 1u);
                    FRESH();
                    const int nA = 1024 / nq, nS = 128 / nq, nG = 256 / nq;
                    if (j < nA) { const int r = nA * x + j, bh = (r / nA) * (16 / nq) + (j % (16 / nq)), qb = 63 - (j / (16 / nq)), b = bh >> 3, hh = bh & 7;
                        const float* kA = a.out + OUT_KP + ((size_t)(l * 2 + b) * 8192) * 512 + hh * 64; const float* vA = a.out + OUT_VP + ((size_t)(l * 2 + b) * 8192) * 512 + hh * 64;
                        attn_unit(lds, Q + (size_t)(b * 8192 + 128 * qb) * 512 + hh * 64, 8, 128 * qb, kA, vA, kA, vA, 8192, 8192, MERGED + (size_t)(b * 8192 + 128 * qb) * 1024 + hh * 64, tid, lane, wave);
                    } else if (j < nA + nS) { const int r = nS * x + (j - nA), b = r >> 3, hh = r & 7;
                        const float* kA = a.in[4] + ((size_t)(l * 16 + b) * 1024) * 512 + hh * 64; const float* vA = a.in[5] + ((size_t)(l * 16 + b) * 1024) * 512 + hh * 64;
                        const float* kB = a.out + OUT_KS + ((size_t)(l * 16 + b) * 16) * 512 + hh * 64; const float* vB = a.out + OUT_VS + ((size_t)(l * 16 + b) * 16) * 512 + hh * 64;
                        attn_unit(lds, Q + (size_t)(TP + 16 * b) * 512 + hh * 64, 1, 1024, kA, vA, kB, vB, 1024, 1040, MERGED + (size_t)(TP + 16 * b) * 1024 + hh * 64, tid, lane, wave);
                    } else if (j < nA + nS + nG) { const int r = nG * x + (j - nA - nS);
                        gla_sample_unit(a, lds, l, r >> 4, (r >> 2) & 3, r & 3, tid);
                    } else { const int r = (1024 / nq) * x + (j - nA - nS - nG), hh = r & 3, c = (r >> 2) & 127, b = r >> 9;
                        gla_a_unit(a, lds, b, c, hh, tid, lane, wave);
                    }
                }
            }
        }
#endif
        GRID_BAR();
#ifndef NO_SCAN
        for (int rep_ = 0; rep_ < REP_SCAN; ++rep_, __syncthreads()) { FRESH(); gla_scan(a, lds, l, tid, lane, wave, bid, G); }
#endif
        GRID_BAR();
#ifndef NO_GLAC
        for (int rep_ = 0; rep_ < REP_GLAC; ++rep_, __syncthreads()) for (int it = bid; it < 1024; it += G) { FRESH(); const int hh = it & 3, c = (it >> 2) & 127, b = it >> 9; gla_c_unit(a, lds, l, b, c, hh, tid, lane, wave); }
#endif
        GRID_BAR();
        {
            pg8::Gemm g{MERGED, WOUT + (size_t)l * DM * DM, TP, DM, DM}; pg8::StaticOrder S; S.init(TP, DM, G, bid);
            EpiResN E{XP, X, mod + (size_t)l * NROWS * NMOD + 2 * DM, a.in[10] + l * DM, mod + (size_t)l * NROWS * NMOD + 4 * DM, H, (float*)(a.ws + WS_ROWSS) + (size_t)l * MT};
            { SResN SE{XS, X, mod + (size_t)l * NROWS * NMOD + 2 * DM, a.in[10] + l * DM, mod + (size_t)l * NROWS * NMOD + 4 * DM, H, (float*)(a.ws + WS_ROWSS) + (size_t)l * MT};
              for (int step = 0; step < 2; ++step) {
                  if ((step == 0) == ((bid & 1) == 0)) { FRESH(); small_gemm<32, DM, false, SResN>(lds, MERGED + (size_t)TP * DM, WOUT + (size_t)l * DM * DM, 8 * 32, SE, tid, lane, wave, bid, G); }
                  else { pg8::gemm_phase<EpiResN, pg8::StaticOrder, true, true>(lds, g, S, E); __syncthreads(); }
              } }
        }
        GRID_BAR();
        {
            pg8::Gemm g{H, WUP + (size_t)l * FF * DM, TP, FF, DM}; pg8::StaticOrder S; S.init(TP, FF, G, bid);
            EpiUpN E{UU, (const float*)(a.ws + WS_ROWSS) + (size_t)l * MT, (const float*)(a.ws + WS_BIASUP) + (size_t)l * NROWS * FF};
            { SUpN SE{UU, (const float*)(a.ws + WS_ROWSS) + (size_t)l * MT, (const float*)(a.ws + WS_BIASUP) + (size_t)l * NROWS * FF};
              for (int step = 0; step < 2; ++step) {
                  if ((step == 0) == ((bid & 1) == 0)) { FRESH(); small_gemm<64, DM, false, SUpN>(lds, H + (size_t)TP * DM, WUP + (size_t)l * FF * DM, 8 * 64, SE, tid, lane, wave, bid, G); }
                  else { pg8::gemm_phase<EpiUpN, pg8::StaticOrder, true, true>(lds, g, S, E); __syncthreads(); }
              } }
        }
        GRID_BAR();
        {
            pg8::Gemm g{UU, WDN + (size_t)l * DM * FF, TP, DM, FF}; pg8::StaticOrder S; S.init(TP, DM, G, bid);
            const int ln = l == 0 ? 1 : 0;
            EpiResN E{X, X, mod + (size_t)l * NROWS * NMOD + 5 * DM, a.in[9] + ln * DM, mod + (size_t)ln * NROWS * NMOD + 1 * DM, l == 0 ? H : (bf16*)nullptr, (float*)(a.ws + WS_ROWSS_IN) + (size_t)ln * MT};
            { const int ln = l == 0 ? 1 : 0;
              SResN SE{X + (size_t)TP * DM, X, mod + (size_t)l * NROWS * NMOD + 5 * DM, a.in[9] + ln * DM, mod + (size_t)ln * NROWS * NMOD + 1 * DM, l == 0 ? H : (bf16*)nullptr, (float*)(a.ws + WS_ROWSS_IN) + (size_t)ln * MT};
              for (int step = 0; step < 2; ++step) {
                  if ((step == 0) == ((bid & 1) == 0)) { FRESH(); small_gemm<32, FF, false, SResN>(lds, UU + (size_t)TP * FF, WDN + (size_t)l * DM * FF, 8 * 32, SE, tid, lane, wave, bid, G); }
                  else { pg8::gemm_phase<EpiResN, pg8::StaticOrder, true, true>(lds, g, S, E); __syncthreads(); }
              } }
        }
        if (l == 0) GRID_BAR();
    }
}

extern "C" void kernel_launch(void* const* d_in, const int* in_sizes, int n_in, void* d_out, int out_size, void* d_ws, size_t ws_size, hipStream_t stream) {
    static int grid = 0;
    if (grid == 0) {
        if (n_in != 20 || ws_size < WS_END) { fprintf(stderr, "kernel_launch: unexpected n_in %d / ws_size %zu (need %zu)\n", n_in, ws_size, (size_t)WS_END); grid = -1; return; }
        int dev = 0, cus = 0, per_cu = 0;
        (void)hipGetDevice(&dev); (void)hipDeviceGetAttribute(&cus, hipDeviceAttributeMultiprocessorCount, dev);
        if (hipFuncSetAttribute((const void*)mk_fwd, hipFuncAttributeMaxDynamicSharedMemorySize, LDS_BYTES) != hipSuccess) { fprintf(stderr, "kernel_launch: hipFuncSetAttribute failed\n"); grid = -1; return; }
        if (hipOccupancyMaxActiveBlocksPerMultiprocessor(&per_cu, (const void*)mk_fwd, 512, LDS_BYTES) != hipSuccess || per_cu < 1) { fprintf(stderr, "kernel_launch: occupancy query says %d\n", per_cu); per_cu = 1; }
        (void)hipGetLastError();
        grid = cus * 1;
        if (grid <= 0) grid = 256;
    }
    if (grid < 0) return;
    if (hipMemsetAsync((char*)d_ws + WS_CTL, 0, CTL_ZERO_BYTES, stream) != hipSuccess) { fprintf(stderr, "kernel_launch: memset failed\n"); return; }
    Args a{};
    for (int i = 0; i < 20; ++i) a.in[i] = (const float*)d_in[i];
    a.out = (float*)d_out; a.ws = (unsigned char*)d_ws; a.never = 0; a.pad = 0;
    void* args[] = {&a};
    hipError_t e = hipLaunchCooperativeKernel((const void*)mk_fwd, dim3(grid), dim3(512), args, LDS_BYTES, stream);
    if (e != hipSuccess) fprintf(stderr, "kernel_launch: cooperative launch failed: %s (grid %d)\n", hipGetErrorString(e), grid);
}
```

```cpp
#include <hip/hip_runtime.h>
#include <hip/hip_cooperative_groups.h>
#include <cstdio>
#include <cstdint>
namespace cg = cooperative_groups;
namespace pg8 {
#define PG8_LAS __attribute__((address_space(3)))
typedef unsigned short bf16_t;
typedef short bf16x8 __attribute__((ext_vector_type(8)));
typedef float f32x4 __attribute__((ext_vector_type(4)));
typedef unsigned u32x4 __attribute__((ext_vector_type(4)));
constexpr int BM = 256, BK = 64, HALF = 128, HTB = HALF * BK * 2  , STAGE_BYTES = 8 * HTB, NXCD = 8, WGM = 8;

__host__ __device__ __forceinline__ int lds_byte(int r, int c) { const int st = (r >> 4) * 2 + (c >> 5), rr = r & 15, cc = c & 31, ob = rr * 64 + cc * 2; return st * 1024 + (ob ^ (((ob >> 9) & 1) << 5)); }
__host__ __device__ __forceinline__ void stage_rc(int b, int& R, int& C) { const int st = b / 1024, sb = b % 1024, swz = sb ^ (((sb >> 9) & 1) << 5); R = (st >> 1) * 16 + swz / 64; C = (st & 1) * 32 + (swz % 64) / 2; }
__host__ __device__ __forceinline__ int perm32(int rho) { const int n = rho >> 4, i = rho & 15; return 8 * (i >> 2) + 4 * n + (i & 3); }

struct Unit { int pm, pn; };
struct Gemm { const bf16_t* A; const bf16_t* Bt; int M, N, K; };

struct StaticOrder {
    int nM, nN, nwg, G, c;
    __host__ __device__ void init(int M, int N, int G_, int c_) { nM = M / BM; nN = N / BM; nwg = nM * nN; G = G_; c = c_; }
    __host__ __device__ bool next(int i, Unit& u) const {
        const long L = (long)i * G + c; if (L >= nwg) return false;
        int wgid = (int)L; { const int q = nwg / NXCD, r = nwg % NXCD, xcd = wgid % NXCD, off = wgid / NXCD; wgid = (xcd < r ? xcd * (q + 1) : r * (q + 1) + (xcd - r) * q) + off; }
        const int nig = WGM * nN, gid = wgid / nig, fm = gid * WGM, gsz = (nM - fm) < WGM ? (nM - fm) : WGM;
        u.pm = fm + ((wgid % nig) % gsz); u.pn = (wgid % nig) / gsz; return true;
    }
    __device__ __forceinline__ void a_ready(const Unit&) const {}
    __device__ __forceinline__ void done(const Unit&) const {}
};

__device__ __forceinline__ unsigned cvt_pk_bf16(float lo, float hi) { unsigned r; asm volatile("v_cvt_pk_bf16_f32 %0, %1, %2" : "=v"(r) : "v"(lo), "v"(hi)); return r; }
template <class Epi, class Sched, bool ALIGN_EPI = false, bool SP2 = false>
__device__ __forceinline__ void gemm_phase(PG8_LAS unsigned char* lds, const Gemm g, const Sched& S, const Epi& E) {
    int tid_ = threadIdx.x; asm volatile("" : "+v"(tid_));
    const int tid = tid_, wid = __builtin_amdgcn_readfirstlane(tid >> 6), lane = tid & 63, wr = wid >> 2, wc = wid & 3, fr = lane & 15, fq = lane >> 4;
    const int K = g.K, nt = K / BK;
    unsigned voffA[2], voffB[2];
#pragma unroll
    for (int i = 0; i < 2; ++i) { int R, C; stage_rc(tid * 16 + i * 8192, R, C); const int Rb = Epi::PERM ? ((R & ~31) + perm32(R & 31)) : R;
        voffA[i] = (unsigned)(R * K + C) * 2u; voffB[i] = (unsigned)(Rb * K + C) * 2u; }
    const size_t kstep = (size_t)(BK * 2);
    const size_t hstep = (size_t)HALF * K * 2;
    const size_t tstep = 2 * hstep;
    const unsigned ldsw = (unsigned)wid * 1024u;
    const int aoff = lds_byte(wr * 64 + fr, fq * 8), boff = lds_byte(wc * 32 + fr, fq * 8);
#define PG8_SA(b, h) (((b) * 2 + (h)) * HTB)
#define PG8_SB(b, h) ((4 + (b) * 2 + (h)) * HTB)
#define PG8_STAGE(bufoff, gbase, voff) do { _Pragma("unroll") for (int _i = 0; _i < 2; ++_i) \
        __builtin_amdgcn_global_load_lds((const unsigned*)((const char*)(gbase) + (voff)[_i]), (PG8_LAS unsigned*)(lds + (bufoff) + ldsw + _i * 8192), 16, 0, 0); } while (0)
#define PG8_LDA(dst, b, h) do { _Pragma("unroll") for (int m = 0; m < 4; ++m) _Pragma("unroll") for (int k = 0; k < 2; ++k) dst[m][k] = *(const PG8_LAS bf16x8*)(lds + PG8_SA(b, h) + aoff + m * 2048 + k * 1024); } while (0)
#define PG8_LDB(dst, b, h) do { _Pragma("unroll") for (int n = 0; n < 2; ++n) _Pragma("unroll") for (int k = 0; k < 2; ++k) dst[n][k] = *(const PG8_LAS bf16x8*)(lds + PG8_SB(b, h) + boff + n * 2048 + k * 1024); } while (0)
#define PG8_MMA(ai, bj, At, Bt) do { __builtin_amdgcn_s_setprio(1); _Pragma("unroll") for (int m = 0; m < 4; ++m) _Pragma("unroll") for (int n = 0; n < 2; ++n) _Pragma("unroll") for (int k = 0; k < 2; ++k) \
        acc[ai][bj][m][n] = __builtin_amdgcn_mfma_f32_16x16x32_bf16(Bt[n][k], At[m][k], acc[ai][bj][m][n], 0, 0, 0); __builtin_amdgcn_s_setprio(0); } while (0)
#define PG8_WAIT_V(n) asm volatile("s_waitcnt vmcnt(" #n ")" ::: "memory")
#define PG8_WAIT_L(n) asm volatile("s_waitcnt lgkmcnt(" #n ")" ::: "memory")
#define PG8_BAR __builtin_amdgcn_s_barrier()
#define PG8_SCHED __builtin_amdgcn_sched_barrier(0)
    Unit cur, nxt; int ui = 0;
    if (!S.next(0, cur)) return;
    f32x4 acc[2][2][4][2];
#pragma unroll
    for (int a = 0; a < 2; ++a)
#pragma unroll
        for (int b = 0; b < 2; ++b)
#pragma unroll
            for (int m = 0; m < 4; ++m)
#pragma unroll
                for (int n = 0; n < 2; ++n) acc[a][b][m][n] = (f32x4){0.f, 0.f, 0.f, 0.f};
    bf16x8 At[4][2], B0[2][2], B1[2][2];
    const char* cA = (const char*)g.A + (size_t)cur.pm * tstep; const char* cB = (const char*)g.Bt + (size_t)cur.pn * tstep;
    S.a_ready(cur);
    if constexpr (SP2) {
        PG8_STAGE(PG8_SB(0, 0), cB, voffB); PG8_STAGE(PG8_SB(0, 1), cB + hstep, voffB); PG8_STAGE(PG8_SA(0, 0), cA, voffA); PG8_STAGE(PG8_SA(0, 1), cA + hstep, voffA);
        if (wr == 1) PG8_BAR;
        PG8_WAIT_V(2); PG8_BAR;
        PG8_STAGE(PG8_SB(1, 0), cB + kstep, voffB); PG8_STAGE(PG8_SA(1, 0), cA + kstep, voffA); PG8_STAGE(PG8_SB(1, 1), cB + hstep + kstep, voffB);
        PG8_WAIT_V(6); PG8_BAR;
    } else {
        PG8_STAGE(PG8_SB(0, 0), cB, voffB); PG8_STAGE(PG8_SA(0, 0), cA, voffA); PG8_STAGE(PG8_SB(0, 1), cB + hstep, voffB); PG8_STAGE(PG8_SA(0, 1), cA + hstep, voffA);
        if (wr == 1) PG8_BAR;
        PG8_WAIT_V(4); PG8_BAR;
        PG8_STAGE(PG8_SB(1, 0), cB + kstep, voffB); PG8_STAGE(PG8_SA(1, 0), cA + kstep, voffA); PG8_STAGE(PG8_SB(1, 1), cB + hstep + kstep, voffB);
        PG8_WAIT_V(6); PG8_BAR;
    }
    for (;;) {
        const bool has_next = S.next(ui + 1, nxt);
        const char* nA = has_next ? (const char*)g.A + (size_t)nxt.pm * tstep : cA; const char* nB = has_next ? (const char*)g.Bt + (size_t)nxt.pn * tstep : cB;
        for (int t = 0; t < nt; t += 2) {
            const bool last = (t == nt - 2);
            const char* a1 = cA + (size_t)(t + 1) * kstep;
            const char* a2 = last ? nA : cA + (size_t)(t + 2) * kstep; const char* b2 = last ? nB : cB + (size_t)(t + 2) * kstep;
            const char* a3 = a2 + kstep; const char* b3 = b2 + kstep;
            if (last && has_next) S.a_ready(nxt);
            if constexpr (SP2) {
            PG8_LDB(B0, 0, 0); PG8_LDB(B1, 0, 1); PG8_SCHED; PG8_LDA(At, 0, 0); PG8_STAGE(PG8_SA(1, 1), a1 + hstep, voffA);
            PG8_WAIT_V(8); PG8_WAIT_L(0); PG8_BAR; PG8_MMA(0, 0, At, B0); PG8_MMA(0, 1, At, B1); PG8_BAR; PG8_SCHED;
            PG8_LDA(At, 0, 1); PG8_STAGE(PG8_SB(0, 0), b2, voffB); PG8_STAGE(PG8_SB(0, 1), b2 + hstep, voffB); PG8_STAGE(PG8_SA(0, 0), a2, voffA);
            PG8_WAIT_V(8); PG8_WAIT_L(0); PG8_BAR; PG8_MMA(1, 0, At, B0); PG8_MMA(1, 1, At, B1); PG8_BAR; PG8_SCHED;
            PG8_LDB(B0, 1, 0); PG8_LDB(B1, 1, 1); PG8_SCHED; PG8_LDA(At, 1, 0); PG8_STAGE(PG8_SA(0, 1), a2 + hstep, voffA);
            PG8_WAIT_V(8); PG8_WAIT_L(0); PG8_BAR; PG8_MMA(0, 0, At, B0); PG8_MMA(0, 1, At, B1); PG8_BAR; PG8_SCHED;
            PG8_LDA(At, 1, 1); PG8_STAGE(PG8_SB(1, 0), b3, voffB); PG8_STAGE(PG8_SB(1, 1), b3 + hstep, voffB); PG8_STAGE(PG8_SA(1, 0), a3, voffA);
            PG8_WAIT_V(8); PG8_WAIT_L(0); PG8_BAR; PG8_MMA(1, 0, At, B0); PG8_MMA(1, 1, At, B1); PG8_BAR; PG8_SCHED;
            } else {
            PG8_LDB(B0, 0, 0); PG8_SCHED; PG8_LDA(At, 0, 0); PG8_STAGE(PG8_SA(1, 1), a1 + hstep, voffA);
            PG8_WAIT_L(8); PG8_BAR; PG8_WAIT_L(0); PG8_MMA(0, 0, At, B0); PG8_BAR; PG8_SCHED;
            PG8_LDB(B1, 0, 1); PG8_STAGE(PG8_SB(0, 0), b2, voffB);
            PG8_BAR; PG8_WAIT_L(0); PG8_MMA(0, 1, At, B1); PG8_BAR;
            PG8_LDA(At, 0, 1); PG8_STAGE(PG8_SA(0, 0), a2, voffA);
            PG8_BAR; PG8_WAIT_L(0); PG8_MMA(1, 0, At, B0); PG8_BAR; PG8_SCHED;
            PG8_STAGE(PG8_SB(0, 1), b2 + hstep, voffB);
            PG8_WAIT_V(6); PG8_BAR; PG8_MMA(1, 1, At, B1); PG8_BAR;
            PG8_LDB(B0, 1, 0); PG8_SCHED; PG8_LDA(At, 1, 0); PG8_STAGE(PG8_SA(0, 1), a2 + hstep, voffA);
            PG8_WAIT_L(8); PG8_BAR; PG8_WAIT_L(0); PG8_MMA(0, 0, At, B0); PG8_BAR; PG8_SCHED;
            PG8_LDB(B1, 1, 1); PG8_STAGE(PG8_SB(1, 0), b3, voffB);
            PG8_BAR; PG8_WAIT_L(0); PG8_MMA(0, 1, At, B1); PG8_BAR;
            PG8_LDA(At, 1, 1); PG8_STAGE(PG8_SA(1, 0), a3, voffA);
            PG8_BAR; PG8_WAIT_L(0); PG8_MMA(1, 0, At, B0); PG8_BAR; PG8_SCHED;
            PG8_STAGE(PG8_SB(1, 1), b3 + hstep, voffB);
            PG8_WAIT_V(6); PG8_BAR; PG8_MMA(1, 1, At, B1); PG8_BAR;
            }
        }
        if constexpr (ALIGN_EPI) { if (wr == 0) PG8_BAR; }
        if constexpr (!Epi::AFTER_DRAIN) { E(acc, cur, wr, wc, fr, fq); S.done(cur); }
        if (!has_next) break;
#pragma unroll
        for (int a = 0; a < 2; ++a)
#pragma unroll
            for (int b = 0; b < 2; ++b)
#pragma unroll
                for (int m = 0; m < 4; ++m)
#pragma unroll
                    for (int n = 0; n < 2; ++n) acc[a][b][m][n] = (f32x4){0.f, 0.f, 0.f, 0.f};
        cur = nxt; cA = nA; cB = nB; ++ui;
        if constexpr (ALIGN_EPI) { if (wr == 1) PG8_BAR; }
    }
    PG8_WAIT_V(0);
    if constexpr (!ALIGN_EPI) { if (wr == 0) PG8_BAR; }
    PG8_BAR;
    if constexpr (Epi::AFTER_DRAIN) { E.fused(acc, cur, wr, wc, fr, fq, lds, wid, lane); S.done(cur); }
#undef PG8_SA
#undef PG8_SB
#undef PG8_STAGE
#undef PG8_LDA
#undef PG8_LDB
#undef PG8_MMA
#undef PG8_WAIT_V
#undef PG8_WAIT_L
#undef PG8_BAR
#undef PG8_SCHED
}
}

#define LAS __attribute__((address_space(3)))
typedef unsigned short bf16;
typedef float f32x4 __attribute__((ext_vector_type(4)));
typedef unsigned u32x4 __attribute__((ext_vector_type(4)));
typedef unsigned u32x2 __attribute__((ext_vector_type(2)));
typedef short bf16x8 __attribute__((ext_vector_type(8)));

constexpr int DM = 1024, TP = 16384, TS = 256, MT = TP + TS, FF = 4096, NING = 3072, NINW = 3088;
constexpr int NMOD = 6144, NROWS = 18;
constexpr float EPS = 1e-6f;
constexpr float LOG2E = 1.4426950408889634f;
constexpr float QSCALE = 0.125f * LOG2E;

constexpr size_t OUT_KP = 17039360, OUT_VP = 33816576, OUT_SP = 50593792, OUT_KS = 50724864, OUT_VS = 50987008, OUT_SS = 51249152;
constexpr size_t MiB = 1u << 20;
constexpr size_t WS_CTL = 0, WS_WIN = 1 * MiB, WS_WOUT = 13 * MiB, WS_WUP = 17 * MiB, WS_WDN = 33 * MiB, WS_MOD = 49 * MiB, WS_H = 50 * MiB,
                 WS_Q = 83 * MiB, WS_QG = 100 * MiB, WS_KG = 109 * MiB, WS_VG = 118 * MiB, WS_OG = 135 * MiB, WS_LOGF = 152 * MiB,
                 WS_MERGED = 169 * MiB, WS_U = 202 * MiB, WS_ACH = 234 * MiB, WS_S = 235 * MiB, WS_BIASIN = 267 * MiB, WS_BIASGR = 267 * MiB + 512 * 1024, WS_WGR = 267 * MiB + 576 * 1024, WS_END = 268 * MiB, WS_UU = WS_Q;
constexpr int LDS_BYTES = 147456, ARGS_OFF = 131072 + 1024;
constexpr size_t WS_ROWSS = 131072, WS_ROWSS_IN = 131072 + 2 * 16640 * 4, CTL_ZERO_BYTES = 131072 + 4 * 16640 * 4;
constexpr size_t WS_BIASUP = 234 * MiB + 384 * 1024;

struct Args { const float* in[20]; float* out; unsigned char* ws; int never; int pad; };

__device__ __forceinline__ unsigned f2bf(float f) { unsigned u = __builtin_bit_cast(unsigned, f); return (u + 0x7fffu + ((u >> 16) & 1u)) >> 16; }
__device__ __forceinline__ unsigned pk2(float lo, float hi) { return pg8::cvt_pk_bf16(lo, hi); }
__device__ __forceinline__ float bf2f(unsigned short b) { return __builtin_bit_cast(float, (unsigned)b << 16); }
__device__ __forceinline__ float bflo(unsigned w) { return __builtin_bit_cast(float, w << 16); }
__device__ __forceinline__ float bfhi(unsigned w) { return __builtin_bit_cast(float, w & 0xffff0000u); }
__device__ __forceinline__ bf16x8 pack8(f32x4 a, f32x4 b) { u32x4 w; w.x = pk2(a.x, a.y); w.y = pk2(a.z, a.w); w.z = pk2(b.x, b.y); w.w = pk2(b.z, b.w); return __builtin_bit_cast(bf16x8, w); }
__device__ __forceinline__ float wave_sum(float v) {
#pragma unroll
    for (int o = 1; o < 64; o <<= 1) v += __shfl_xor(v, o);
    return v;
}
__device__ __forceinline__ int modrow(int m) { return m < TP ? (m >> 13) : 2 + ((m - TP) >> 4); }
__device__ __forceinline__ float silu_f(float x) { return x / (1.f + __expf(-x)); }
__device__ __forceinline__ void* ld_ptr(LAS unsigned char* p) { const unsigned lo = *(volatile LAS unsigned*)p, hi = *(volatile LAS unsigned*)(p + 4);
    return (void*)(((unsigned long long)(unsigned)__builtin_amdgcn_readfirstlane((int)hi) << 32) | (unsigned)__builtin_amdgcn_readfirstlane((int)lo)); }
#ifndef WT_STORES
#define WT_STORES 0
#endif
__device__ __forceinline__ void st16(void* ptr, u32x4 v) {
#if WT_STORES
    asm volatile("global_store_dwordx4 %0, %1, off sc1\n\ts_nop 1" :: "v"(ptr), "v"(v));
#else
    *(u32x4*)ptr = v;
#endif
}
__device__ __forceinline__ void st16(void* ptr, f32x4 v) { st16(ptr, __builtin_bit_cast(u32x4, v)); }
#define LDS_WAIT() asm volatile("s_waitcnt lgkmcnt(0)" ::: "memory")
#define MFMA16(a, b, c) __builtin_amdgcn_mfma_f32_16x16x32_bf16((a), (b), (c), 0, 0, 0)

struct EpiIn {
    static constexpr bool PERM = true, AFTER_DRAIN = false;
    int l; float* out; bf16 *Q, *QG, *KG, *VG, *OG; const float *qn, *kn; const float* rowss; const float* bias;
    __device__ __forceinline__ void operator()(const pg8::f32x4 (&acc0)[2][2][4][2], const pg8::Unit& u, int wr, int wc, int fr, int fq) const {
        const int pn = u.pn;
        f32x4 bv[2][2];
        { const float* bp = bias + (size_t)((u.pm * 256) >> 13) * NING + 256 * pn + 64 * wc + 8 * fq;
#pragma unroll
          for (int bj = 0; bj < 2; ++bj)
#pragma unroll
              for (int n = 0; n < 2; ++n) bv[bj][n] = *(const f32x4*)(bp + 32 * bj + 4 * n); }
        f32x4 nw[2][2];
        if (pn < 4) {
            const float* np = (pn < 2 ? qn : kn) + 8 * fq;
#pragma unroll
            for (int bj = 0; bj < 2; ++bj)
#pragma unroll
                for (int n = 0; n < 2; ++n) nw[bj][n] = *(const f32x4*)(np + 32 * bj + 4 * n);
        }
#pragma unroll
        for (int ai = 0; ai < 2; ++ai)
#pragma unroll
            for (int m = 0; m < 4; ++m) {
                const int row = u.pm * 256 + ai * 128 + wr * 64 + m * 16 + fr;
                const int cin = 64 * wc + 8 * fq;
                const float rs0 = rsqrtf(rowss[row] * (1.f / DM) + EPS);
                f32x4 av[2][2];
#pragma unroll
                for (int bj = 0; bj < 2; ++bj)
#pragma unroll
                    for (int n = 0; n < 2; ++n) av[bj][n] = acc0[ai][bj][m][n] * rs0 + bv[bj][n];
                if (pn < 4) {
                    float ss = 0.f;
#pragma unroll
                    for (int bj = 0; bj < 2; ++bj)
#pragma unroll
                        for (int n = 0; n < 2; ++n) { const f32x4 v = av[bj][n]; ss += (v.x * v.x + v.y * v.y) + (v.z * v.z + v.w * v.w); }
                    ss += __shfl_xor(ss, 16); ss += __shfl_xor(ss, 32);
                    const float rstd = rsqrtf(ss * (1.f / 64.f) + EPS);
                    if (pn < 2) {
                        bf16* qp = Q + (size_t)row * 512 + 256 * pn + cin;
#pragma unroll
                        for (int bj = 0; bj < 2; ++bj) {
                            const f32x4 a = av[bj][0] * nw[bj][0] * (rstd * QSCALE), b = av[bj][1] * nw[bj][1] * (rstd * QSCALE);
                            u32x4 w; w.x = pk2(a.x, a.y); w.y = pk2(a.z, a.w); w.z = pk2(b.x, b.y); w.w = pk2(b.z, b.w);
                            st16(qp + 32 * bj, w);
                        }
                    } else {
                        float* kp = (row < TP ? out + OUT_KP + ((size_t)l * TP + row) * 512 : out + OUT_KS + ((size_t)l * TS + (row - TP)) * 512) + 256 * (pn - 2) + cin;
#pragma unroll
                        for (int bj = 0; bj < 2; ++bj)
#pragma unroll
                            for (int n = 0; n < 2; ++n) st16(kp + 32 * bj + 4 * n, (f32x4)(av[bj][n] * nw[bj][n] * rstd));
                    }
                } else if (pn < 6) {
                    float* vp = (row < TP ? out + OUT_VP + ((size_t)l * TP + row) * 512 : out + OUT_VS + ((size_t)l * TS + (row - TP)) * 512) + 256 * (pn - 4) + cin;
#pragma unroll
                    for (int bj = 0; bj < 2; ++bj)
#pragma unroll
                        for (int n = 0; n < 2; ++n) st16(vp + 32 * bj + 4 * n, (f32x4)(av[bj][n]));
                } else {
                    bf16* dp; float sc = 1.f;
                    if (pn == 6) { dp = QG + (size_t)row * 256 + cin; sc = 0.125f; }
                    else if (pn == 7) dp = KG + (size_t)row * 256 + cin;
                    else if (pn < 10) dp = VG + (size_t)row * 512 + 256 * (pn - 8) + cin;
                    else dp = OG + (size_t)row * 512 + 256 * (pn - 10) + cin;
#pragma unroll
                    for (int bj = 0; bj < 2; ++bj) {
                        const f32x4 a = av[bj][0] * sc, b = av[bj][1] * sc;
                        u32x4 w; w.x = pk2(a.x, a.y); w.y = pk2(a.z, a.w); w.z = pk2(b.x, b.y); w.w = pk2(b.z, b.w);
                        st16(dp + 32 * bj, w);
                    }
                }
            }
    }
};
struct EpiRes {
    static constexpr bool PERM = false, AFTER_DRAIN = false;
    const float* srcp; const float* srcs; float* X; const float* gate;
    __device__ __forceinline__ void operator()(const pg8::f32x4 (&acc)[2][2][4][2], const pg8::Unit& u, int wr, int wc, int fr, int fq) const {
        const int col0 = u.pn * 256 + wc * 32 + 4 * fq;
#pragma unroll
        for (int ai = 0; ai < 2; ++ai)
#pragma unroll
            for (int m = 0; m < 4; ++m) {
                const int row = u.pm * 256 + ai * 128 + wr * 64 + m * 16 + fr;
                const float* sp = (row < TP ? srcp + (size_t)row * DM : srcs + (size_t)(row - TP) * DM) + col0;
                const float* gp = gate + (size_t)modrow(row) * NMOD + col0;
                float* xp = X + (size_t)row * DM + col0;
#pragma unroll
                for (int bj = 0; bj < 2; ++bj)
#pragma unroll
                    for (int n = 0; n < 2; ++n) {
                        const f32x4 s = *(const f32x4*)(sp + bj * 128 + n * 16), g = *(const f32x4*)(gp + bj * 128 + n * 16);
                        st16(xp + bj * 128 + n * 16, (f32x4)(s + g * acc[ai][bj][m][n]));
                    }
            }
    }
};
struct EpiUp {
    static constexpr bool PERM = true, AFTER_DRAIN = false;
    bf16* O;
    __device__ __forceinline__ void operator()(const pg8::f32x4 (&acc)[2][2][4][2], const pg8::Unit& u, int wr, int wc, int fr, int fq) const {
        const int col0 = u.pn * 256 + wc * 32 + 8 * fq;
#pragma unroll
        for (int ai = 0; ai < 2; ++ai)
#pragma unroll
            for (int m = 0; m < 4; ++m) {
                bf16* rp = O + (size_t)(u.pm * 256 + ai * 128 + wr * 64 + m * 16 + fr) * FF + col0;
#pragma unroll
                for (int bj = 0; bj < 2; ++bj) {
                    f32x4 a = acc[ai][bj][m][0], b = acc[ai][bj][m][1];
                    a = __builtin_elementwise_max(a, (f32x4){0.f, 0.f, 0.f, 0.f}); b = __builtin_elementwise_max(b, (f32x4){0.f, 0.f, 0.f, 0.f});
                    a = a * a; b = b * b;
                    u32x4 w; w.x = pk2(a.x, a.y); w.y = pk2(a.z, a.w); w.z = pk2(b.x, b.y); w.w = pk2(b.z, b.w);
                    st16(rp + bj * 128, w);
                }
            }
    }
};

struct EpiResN {
    static constexpr bool PERM = true, AFTER_DRAIN = false;
    const float* srcp; float* X; const float* gate; const float* nw; const float* scl; bf16* Hout; float* rowss;
    __device__ __forceinline__ void operator()(const pg8::f32x4 (&acc)[2][2][4][2], const pg8::Unit& u, int wr, int wc, int fr, int fq) const {
        const int col0 = u.pn * 256 + wc * 32 + 8 * fq;
        const int mr = (u.pm * 256) >> 13;
        f32x4 wm[2][2], gv[2][2];
#pragma unroll
        for (int bj = 0; bj < 2; ++bj)
#pragma unroll
            for (int n = 0; n < 2; ++n) { const int c = col0 + bj * 128 + 4 * n;
                wm[bj][n] = Hout ? *(const f32x4*)(nw + c) * (*(const f32x4*)(scl + (size_t)mr * NMOD + c) + 1.0f) : (f32x4){0.f, 0.f, 0.f, 0.f}; gv[bj][n] = *(const f32x4*)(gate + (size_t)mr * NMOD + c); }
#pragma unroll
        for (int ai = 0; ai < 2; ++ai)
#pragma unroll
            for (int m = 0; m < 4; ++m) {
                const int row = u.pm * 256 + ai * 128 + wr * 64 + m * 16 + fr;
                const float* sp = srcp + (size_t)row * DM + col0; float* xp = X + (size_t)row * DM + col0; bf16* hp = Hout + (size_t)row * DM + col0;
                float ss = 0.f;
#pragma unroll
                for (int bj = 0; bj < 2; ++bj) {
                    const f32x4 x0 = *(const f32x4*)(sp + bj * 128) + gv[bj][0] * acc[ai][bj][m][0], x1 = *(const f32x4*)(sp + bj * 128 + 4) + gv[bj][1] * acc[ai][bj][m][1];
                    st16(xp + bj * 128, (f32x4)(x0)); st16(xp + bj * 128 + 4, (f32x4)(x1));
                    ss += (x0.x * x0.x + x0.y * x0.y) + (x0.z * x0.z + x0.w * x0.w) + (x1.x * x1.x + x1.y * x1.y) + (x1.z * x1.z + x1.w * x1.w);
                    if (Hout) { const f32x4 h0 = x0 * wm[bj][0], h1 = x1 * wm[bj][1];
                    u32x4 w; w.x = pk2(h0.x, h0.y); w.y = pk2(h0.z, h0.w); w.z = pk2(h1.x, h1.y); w.w = pk2(h1.z, h1.w);
                    st16(hp + bj * 128, w); }
                }
                ss += __shfl_xor(ss, 16); ss += __shfl_xor(ss, 32);
                if (Hout && fq == 0) unsafeAtomicAdd(rowss + row, ss);
            }
    }
};
struct EpiUpN {
    static constexpr bool PERM = true, AFTER_DRAIN = false;
    bf16* O; const float* rowss; const float* bias;
    __device__ __forceinline__ void operator()(const pg8::f32x4 (&acc)[2][2][4][2], const pg8::Unit& u, int wr, int wc, int fr, int fq) const {
        const int col0 = u.pn * 256 + wc * 32 + 8 * fq;
        const int mr = (u.pm * 256) >> 13;
        f32x4 bv[2][2];
#pragma unroll
        for (int bj = 0; bj < 2; ++bj)
#pragma unroll
            for (int n = 0; n < 2; ++n) bv[bj][n] = *(const f32x4*)(bias + (size_t)mr * FF + col0 + bj * 128 + 4 * n);
#pragma unroll
        for (int ai = 0; ai < 2; ++ai)
#pragma unroll
            for (int m = 0; m < 4; ++m) {
                const int row = u.pm * 256 + ai * 128 + wr * 64 + m * 16 + fr;
                const float rstd = rsqrtf(rowss[row] * (1.f / DM) + EPS);
                bf16* rp = O + (size_t)row * FF + col0;
#pragma unroll
                for (int bj = 0; bj < 2; ++bj) {
                    f32x4 a = acc[ai][bj][m][0] * rstd + bv[bj][0], b = acc[ai][bj][m][1] * rstd + bv[bj][1];
                    a = __builtin_elementwise_max(a, (f32x4){0.f, 0.f, 0.f, 0.f}); b = __builtin_elementwise_max(b, (f32x4){0.f, 0.f, 0.f, 0.f});
                    a = a * a; b = b * b;
                    u32x4 w; w.x = pk2(a.x, a.y); w.y = pk2(a.z, a.w); w.z = pk2(b.x, b.y); w.w = pk2(b.z, b.w);
                    st16(rp + bj * 128, w);
                }
            }
    }
};

__device__ __forceinline__ void transpose_item(const float* W, int ldw, int k0, int c0, bf16* WT, int K, int r0, LAS float* scr, int lane) {
#pragma unroll 8
    for (int i = 0; i < 32; ++i) { const int kk = 2 * i + (lane >> 5); scr[kk * 33 + (lane & 31)] = W[(size_t)(k0 + kk) * ldw + c0 + (lane & 31)]; }
    LDS_WAIT();
    const int c = lane & 7;
#pragma unroll
    for (int j = 0; j < 4; ++j) { const int n = (lane >> 3) + 8 * j; const LAS float* s = scr + (8 * c) * 33 + n;
        u32x4 o; o.x = pk2(s[0 * 33], s[1 * 33]); o.y = pk2(s[2 * 33], s[3 * 33]); o.z = pk2(s[4 * 33], s[5 * 33]); o.w = pk2(s[6 * 33], s[7 * 33]);
        *(u32x4*)(WT + (size_t)(r0 + n) * K + k0 + 8 * c) = o; }
    LDS_WAIT();
}

__device__ __forceinline__ void gemv18_item(LAS float* sc, LAS float* red, const float* W, int ldw, int n0, float* out, int ostride, const float* addv, int tid, int lane, int wave) {
    const int ksub = lane >> 4, c4 = (lane & 15) * 4;
    f32x4 acc[18];
#pragma unroll
    for (int r = 0; r < 18; ++r) acc[r] = (f32x4){0.f, 0.f, 0.f, 0.f};
    const float* wbase = W + (size_t)(wave * 128 + ksub) * ldw + n0 + c4;
#pragma unroll 4
    for (int st = 0; st < 32; ++st) {
        const f32x4 wv = *(const f32x4*)(wbase + (size_t)st * 4 * ldw);
        const LAS f32x4* sp = (const LAS f32x4*)(sc + (wave * 128 + st * 4 + ksub) * 20);
        const f32x4 s0 = sp[0], s1 = sp[1], s2 = sp[2], s3 = sp[3], s4 = sp[4];
        acc[0] += s0.x * wv; acc[1] += s0.y * wv; acc[2] += s0.z * wv; acc[3] += s0.w * wv;
        acc[4] += s1.x * wv; acc[5] += s1.y * wv; acc[6] += s1.z * wv; acc[7] += s1.w * wv;
        acc[8] += s2.x * wv; acc[9] += s2.y * wv; acc[10] += s2.z * wv; acc[11] += s2.w * wv;
        acc[12] += s3.x * wv; acc[13] += s3.y * wv; acc[14] += s3.z * wv; acc[15] += s3.w * wv;
        acc[16] += s4.x * wv; acc[17] += s4.y * wv;
    }
#pragma unroll
    for (int r = 0; r < 18; ++r) {
#pragma unroll
        for (int j = 0; j < 4; ++j) { float v = acc[r][j]; v += __shfl_xor(v, 16); v += __shfl_xor(v, 32); acc[r][j] = v; }
        if (lane < 16) *(LAS f32x4*)(red + (wave * 18 + r) * 64 + c4) = acc[r];
    }
    __syncthreads();
    for (int idx = tid; idx < 1152; idx += 512) { const int r = idx >> 6, c = idx & 63; float s = addv ? addv[n0 + c] : 0.f;
#pragma unroll
        for (int w = 0; w < 8; ++w) s += red[(w * 18 + r) * 64 + c];
        out[(size_t)r * ostride + n0 + c] = s; }
    __syncthreads();
}

__device__ __forceinline__ void phase_prologue(const Args& a, LAS unsigned char* lds, int tid, int lane, int wave, int G, int bid) {
    const float* cp = a.in[2]; const float* cs = a.in[3]; const float* w_ada = a.in[7]; const float* b_ada = a.in[8];
    float* mod = (float*)(a.ws + WS_MOD);
    LAS float* sc = (LAS float*)lds;
    LAS float* red = (LAS float*)(lds + 81920);
    if (bid < 192) {
        for (int idx = tid; idx < 20 * 1024; idx += 512) { const int r = idx >> 10, k = idx & 1023; float v = 0.f;
            if (r < 18) { const float c = r < 2 ? cp[r * 1024 + k] : cs[(r - 2) * 1024 + k]; v = silu_f(c); }
            sc[k * 20 + r] = v; }
        __syncthreads();
        for (int it = bid; it < 192; it += G) {
            const int l = it / 96, n0 = (it % 96) * 64;
            gemv18_item(sc, red, w_ada + (size_t)l * 1024 * NMOD, NMOD, n0, mod + (size_t)l * NROWS * NMOD, NMOD, b_ada + l * NMOD, tid, lane, wave);
        }
    }
}

__device__ __forceinline__ void weight_copies(const Args& a, LAS unsigned char* lds, int lane, int wave, int G, int bid) {
    LAS float* scr = (LAS float*)(lds + wave * 16384);
    const int vb = (bid + 30) % G, gw = vb * 8 + wave, NGW = G * 8;
    bf16* WIN = (bf16*)(a.ws + WS_WIN); bf16* WOUT = (bf16*)(a.ws + WS_WOUT); bf16* WUP = (bf16*)(a.ws + WS_WUP); bf16* WDN = (bf16*)(a.ws + WS_WDN);
    for (int it = gw; it < 12288 + 32; it += NGW) {
        if (it >= 12288) { const int r2 = it - 12288, l2 = r2 >> 4, kb = r2 & 15;
            transpose_item(a.in[11] + (size_t)l2 * DM * NINW, NINW, 64 * kb, 2560, (bf16*)(a.ws + WS_WGR) + (size_t)l2 * 32 * DM, DM, 0, scr, lane); continue; }
        const int l = it / 6144; int r = it % 6144;
        if (r < 1536) { const int kb = r / 96, nb = r % 96, pn = nb >> 3, q = nb & 7, bj = q >> 2, wc = q & 3, oc = 256 * pn + 64 * wc + 32 * bj, src = oc < 2560 ? oc : oc + 16;
            transpose_item(a.in[11] + (size_t)l * DM * NINW, NINW, 64 * kb, src, WIN + (size_t)l * NING * DM, DM, 32 * nb, scr, lane); }
        else if (r < 2048) { r -= 1536; const int kb = r / 32, nb = r % 32;
            transpose_item(a.in[17] + (size_t)l * DM * DM, DM, 64 * kb, 32 * nb, WOUT + (size_t)l * DM * DM, DM, 32 * nb, scr, lane); }
        else if (r < 4096) { r -= 2048; const int kb = r / 128, nb = r % 128;
            transpose_item(a.in[18] + (size_t)l * DM * FF, FF, 64 * kb, 32 * nb, WUP + (size_t)l * FF * DM, DM, 32 * nb, scr, lane); }
        else { r -= 4096; const int kb = r / 32, nb = r % 32;
            transpose_item(a.in[19] + (size_t)l * FF * DM, DM, 64 * kb, 32 * nb, WDN + (size_t)l * DM * FF, FF, 32 * nb, scr, lane); }
    }
}

__device__ __forceinline__ void prep_rows(const Args& a, int m0, int nrow, int lane) {
    const float* mod = (const float*)(a.ws + WS_MOD); const float* nw = a.in[9];
    bf16* H = (bf16*)(a.ws + WS_H); float* rowss = (float*)(a.ws + WS_ROWSS_IN);
    f32x4 wmv[4];
    { const float* mr = mod + (size_t)modrow(m0) * NMOD + 4 * lane;
#pragma unroll
      for (int j = 0; j < 4; ++j) wmv[j] = *(const f32x4*)(nw + 4 * lane + 256 * j) * (*(const f32x4*)(mr + DM + 256 * j) + 1.0f); }
    for (int rr = 0; rr < nrow; ++rr) {
        const int m = m0 + rr;
        const float* xr = (m < TP ? a.in[0] + (size_t)m * DM : a.in[1] + (size_t)(m - TP) * DM) + 4 * lane;
        f32x4 v[4]; float ss = 0.f;
#pragma unroll
        for (int j = 0; j < 4; ++j) { v[j] = *(const f32x4*)(xr + 256 * j); ss += (v[j].x * v[j].x + v[j].y * v[j].y) + (v[j].z * v[j].z + v[j].w * v[j].w); }
        ss = wave_sum(ss);
        if (lane == 0) rowss[m] = ss;
        bf16* hr = H + (size_t)m * DM + 4 * lane;
#pragma unroll
        for (int j = 0; j < 4; ++j) { const f32x4 o = v[j] * wmv[j]; u32x2 pk; pk.x = pk2(o.x, o.y); pk.y = pk2(o.z, o.w); *(u32x2*)(hr + 256 * j) = pk; }
    }
}
__device__ __forceinline__ void prep_phase(const Args& a, LAS unsigned char* lds, int tid, int lane, int wave, int G, int bid) {
    const float* mod = (const float*)(a.ws + WS_MOD);
    {
        LAS float* sc = (LAS float*)lds; LAS float* red = (LAS float*)(lds + 81920);
        for (int it = bid; it < 226; it += G) {
            const int ll = it / 113, j = it % 113;
            const float* mm = mod + (size_t)ll * NROWS * NMOD + ((j >= 48 && j < 112) ? 3 * DM : 0);
            for (int idx = tid; idx < 20 * 1024; idx += 512) { const int r = idx >> 10, k = idx & 1023; sc[k * 20 + r] = r < 18 ? mm[(size_t)r * NMOD + k] : 0.f; }
            __syncthreads();
            if (j < 48) gemv18_item(sc, red, a.in[11] + (size_t)ll * DM * NINW + (64 * j < 2560 ? 64 * j : 64 * j + 16), NINW, 0, (float*)(a.ws + WS_BIASIN) + (size_t)ll * NROWS * NING + 64 * j, NING, nullptr, tid, lane, wave);
            else if (j < 112) gemv18_item(sc, red, a.in[18] + (size_t)ll * DM * FF + 64 * (j - 48), FF, 0, (float*)(a.ws + WS_BIASUP) + (size_t)ll * NROWS * FF + 64 * (j - 48), FF, nullptr, tid, lane, wave);
            else gemv18_item(sc, red, a.in[11] + (size_t)ll * DM * NINW + 2560, NINW, 0, (float*)(a.ws + WS_BIASGR) + (size_t)ll * NROWS * 64, 64, nullptr, tid, lane, wave);
        }
        __syncthreads();
    }
    weight_copies(a, lds, lane, wave, G, bid);
    const int gw = bid * 8 + wave, NGW = G * 8;
    for (int gi = gw; gi < TP / 2; gi += NGW) prep_rows(a, 2 * gi, 2, lane);
    if (wave == 0) for (int s = bid; s < TS; s += G) prep_rows(a, TP + s, 1, lane);
}

template <int TN, int K, bool PERMIN>
__device__ __forceinline__ void sg_compute(f32x4 (&acc)[2][TN / 16], const bf16* A, const bf16* Bt, int rt, int ct, int lane, int wave) {
    constexpr int NCB = TN / 16, KW = K / 8;
    const int fr = lane & 15, fq = lane >> 4;
#pragma unroll
    for (int i = 0; i < 2; ++i)
#pragma unroll
        for (int j = 0; j < NCB; ++j) acc[i][j] = (f32x4){0.f, 0.f, 0.f, 0.f};
    const bf16* ap = A + (size_t)(32 * rt + fr) * K + wave * KW + 8 * fq;
    const bf16* bp[NCB];
#pragma unroll
    for (int cb = 0; cb < NCB; ++cb) {
        int row;
        if (PERMIN) { const int pn = ct >> 2, wc = ct & 3; row = 256 * pn + 128 * (cb >> 1) + 32 * wc + 16 * (cb & 1) + fr; }
        else row = ct * TN + 16 * cb + fr;
        bp[cb] = Bt + (size_t)row * K + wave * KW + 8 * fq;
    }
#pragma unroll 4
    for (int ks = 0; ks < KW / 32; ++ks) {
        const bf16x8 a0 = *(const bf16x8*)(ap + 32 * ks), a1 = *(const bf16x8*)(ap + (size_t)16 * K + 32 * ks);
#pragma unroll
        for (int cb = 0; cb < NCB; ++cb) {
            const bf16x8 bfr = *(const bf16x8*)(bp[cb] + 32 * ks);
            acc[0][cb] = MFMA16(bfr, a0, acc[0][cb]); acc[1][cb] = MFMA16(bfr, a1, acc[1][cb]);
        }
    }
}
template <int TN, class Epi>
__device__ __forceinline__ void sg_finish(LAS unsigned char* lds, const f32x4 (&acc)[2][TN / 16], int rt, int ct, const Epi& E, int tid, int lane, int wave) {
    constexpr int NCB = TN / 16, NB = 2 * NCB, PW = NB * 1088;
    const int fr = lane & 15, fq = lane >> 4;
#pragma unroll
    for (int rb = 0; rb < 2; ++rb)
#pragma unroll
        for (int cb = 0; cb < NCB; ++cb) *(LAS f32x4*)(lds + wave * PW + (rb * NCB + cb) * 1088 + fq * 272 + fr * 16) = acc[rb][cb];
    __syncthreads();
    {
        const int r = tid >> 4, q = tid & 15;
        f32x4 v = (f32x4){0.f, 0.f, 0.f, 0.f};
        if (q < TN / 4) {
            const int off = ((r >> 4) * NCB + (q >> 2)) * 1088 + (q & 3) * 272 + (r & 15) * 16;
#pragma unroll
            for (int w = 0; w < 8; ++w) v += *(const LAS f32x4*)(lds + w * PW + off);
        }
        if (q < TN / 4) v = E.pre(TP + 32 * rt + r, ct * TN + 4 * q, v);
        float ss = (v.x * v.x + v.y * v.y) + (v.z * v.z + v.w * v.w);
        ss += __shfl_xor(ss, 1); ss += __shfl_xor(ss, 2); ss += __shfl_xor(ss, 4); ss += __shfl_xor(ss, 8);
        if (q < TN / 4) E(TP + 32 * rt + r, ct * TN + 4 * q, v, ss);
    }
    __syncthreads();
}
template <int TN, int K, bool PERMIN, class Epi>
__device__ __forceinline__ void small_gemm(LAS unsigned char* lds, const bf16* A, const bf16* Bt, int ntiles, const Epi& E, int tid, int lane, int wave, int bid, int G) {
    for (int it = bid; it < ntiles; it += 2 * G) {
        const bool two = it + G < ntiles; const int it1 = two ? it + G : it;
        f32x4 acc0[2][TN / 16], acc1[2][TN / 16];
        if (two) {
            sg_compute<TN, K, PERMIN>(acc0, A, Bt, it & 7, it >> 3, lane, wave);
            sg_compute<TN, K, PERMIN>(acc1, A, Bt, it1 & 7, it1 >> 3, lane, wave);
            sg_finish<TN, Epi>(lds, acc0, it & 7, it >> 3, E, tid, lane, wave);
            sg_finish<TN, Epi>(lds, acc1, it1 & 7, it1 >> 3, E, tid, lane, wave);
        } else {
            sg_compute<TN, K, PERMIN>(acc0, A, Bt, it & 7, it >> 3, lane, wave);
            sg_finish<TN, Epi>(lds, acc0, it & 7, it >> 3, E, tid, lane, wave);
        }
    }
}
struct SIn {
    int l; float* out; bf16 *Q, *QG, *KG, *VG, *OG; const float *qn, *kn; const float* rowss; const float* bias;
    __device__ __forceinline__ f32x4 pre(int m, int col, f32x4 v) const { return v * rsqrtf(rowss[m] * (1.f / DM) + EPS) + *(const f32x4*)(bias + (size_t)modrow(m) * NING + col); }
    template <int NCB> __device__ __forceinline__ void row(int m, int colbase, const f32x4 (&acc)[NCB]) const {
        float ss = 0.f;
#pragma unroll
        for (int cb = 0; cb < NCB; ++cb) ss += (acc[cb].x * acc[cb].x + acc[cb].y * acc[cb].y) + (acc[cb].z * acc[cb].z + acc[cb].w * acc[cb].w);
        ss += __shfl_xor(ss, 16); ss += __shfl_xor(ss, 32);
#pragma unroll
        for (int cb = 0; cb < NCB; ++cb) (*this)(m, colbase + 16 * cb, acc[cb], ss);
    }
    __device__ __forceinline__ void operator()(int m, int col, f32x4 v, float ss) const {
        const int pn = col >> 8; const size_t ms = (size_t)l * TS + (m - TP);
        if (pn < 4) {
            const float rstd = rsqrtf(ss * (1.f / 64.f) + EPS);
            const f32x4 w = *(const f32x4*)((pn < 2 ? qn : kn) + (col & 63));
            if (pn < 2) { const f32x4 o = v * w * (rstd * QSCALE); u32x2 p; p.x = pk2(o.x, o.y); p.y = pk2(o.z, o.w); *(u32x2*)(Q + (size_t)m * 512 + col) = p; }
            else *(f32x4*)(out + OUT_KS + ms * 512 + (col - 512)) = v * w * rstd;
        } else if (pn < 6) *(f32x4*)(out + OUT_VS + ms * 512 + (col - 1024)) = v;
        else {
            bf16* dp; float sc = 1.f;
            if (pn == 6) { dp = QG + (size_t)m * 256 + (col - 1536); sc = 0.125f; }
            else if (pn == 7) dp = KG + (size_t)m * 256 + (col - 1792);
            else if (pn < 10) dp = VG + (size_t)m * 512 + (col - 2048);
            else dp = OG + (size_t)m * 512 + (col - 2560);
            u32x2 p; p.x = pk2(v.x * sc, v.y * sc); p.y = pk2(v.z * sc, v.w * sc); *(u32x2*)dp = p;
        }
    }
};
struct SRes {
    const float* srcs; float* X; const float* gate;
    __device__ __forceinline__ f32x4 pre(int, int, f32x4 v) const { return v; }
    __device__ __forceinline__ void operator()(int m, int col, f32x4 v, float) const {
        const f32x4 s = *(const f32x4*)(srcs + (size_t)(m - TP) * DM + col), g = *(const f32x4*)(gate + (size_t)modrow(m) * NMOD + col);
        *(f32x4*)(X + (size_t)m * DM + col) = s + g * v;
    }
};
struct SUp {
    bf16* O;
    __device__ __forceinline__ f32x4 pre(int, int, f32x4 v) const { return v; }
    __device__ __forceinline__ void operator()(int m, int col, f32x4 v, float) const {
        v = __builtin_elementwise_max(v, (f32x4){0.f, 0.f, 0.f, 0.f}); v = v * v;
        u32x2 p; p.x = pk2(v.x, v.y); p.y = pk2(v.z, v.w); *(u32x2*)(O + (size_t)m * FF + col) = p;
    }
};

struct SResN {
    const float* srcs; float* X; const float* gate; const float* nw; const float* scl; bf16* Hout; float* rowss;
    __device__ __forceinline__ f32x4 pre(int, int, f32x4 v) const { return v; }
    template <int NCB> __device__ __forceinline__ void row(int m, int colbase, const f32x4 (&acc)[NCB]) const {
        const int mr = modrow(m); float ss = 0.f;
#pragma unroll
        for (int cb = 0; cb < NCB; ++cb) { const int col = colbase + 16 * cb;
            const f32x4 x = *(const f32x4*)(srcs + (size_t)(m - TP) * DM + col) + *(const f32x4*)(gate + (size_t)mr * NMOD + col) * acc[cb];
            *(f32x4*)(X + (size_t)m * DM + col) = x;
            if (Hout) { const f32x4 h = x * *(const f32x4*)(nw + col) * (*(const f32x4*)(scl + (size_t)mr * NMOD + col) + 1.0f);
                u32x2 pq; pq.x = pk2(h.x, h.y); pq.y = pk2(h.z, h.w); *(u32x2*)(Hout + (size_t)m * DM + col) = pq; }
            ss += (x.x * x.x + x.y * x.y) + (x.z * x.z + x.w * x.w); }
        ss += __shfl_xor(ss, 16); ss += __shfl_xor(ss, 32);
        if (Hout && (colbase & 15) == 0) unsafeAtomicAdd(rowss + m, ss);
    }
    __device__ __forceinline__ void operator()(int m, int col, f32x4 v, float) const {
        const int mr = modrow(m);
        const f32x4 x = *(const f32x4*)(srcs + (size_t)(m - TP) * DM + col) + *(const f32x4*)(gate + (size_t)mr * NMOD + col) * v;
        *(f32x4*)(X + (size_t)m * DM + col) = x;
        if (Hout) { const f32x4 h = x * *(const f32x4*)(nw + col) * (*(const f32x4*)(scl + (size_t)mr * NMOD + col) + 1.0f);
        u32x2 p; p.x = pk2(h.x, h.y); p.y = pk2(h.z, h.w); *(u32x2*)(Hout + (size_t)m * DM + col) = p; }
        float ss = (x.x * x.x + x.y * x.y) + (x.z * x.z + x.w * x.w);
        ss += __shfl_xor(ss, 1); ss += __shfl_xor(ss, 2); ss += __shfl_xor(ss, 4);
        if (Hout && ((col >> 2) & 7) == 0) unsafeAtomicAdd(rowss + m, ss);
    }
};
struct SUpN {
    bf16* O; const float* rowss; const float* bias;
    __device__ __forceinline__ f32x4 pre(int, int, f32x4 v) const { return v; }
    template <int NCB> __device__ __forceinline__ void row(int m, int colbase, const f32x4 (&acc)[NCB]) const {
#pragma unroll
        for (int cb = 0; cb < NCB; ++cb) (*this)(m, colbase + 16 * cb, acc[cb], 0.f);
    }
    __device__ __forceinline__ void operator()(int m, int col, f32x4 v, float) const {
        const float rstd = rsqrtf(rowss[m] * (1.f / DM) + EPS);
        v = v * rstd + *(const f32x4*)(bias + (size_t)modrow(m) * FF + col);
        v = __builtin_elementwise_max(v, (f32x4){0.f, 0.f, 0.f, 0.f}); v = v * v;
        u32x2 p; p.x = pk2(v.x, v.y); p.y = pk2(v.z, v.w); *(u32x2*)(O + (size_t)m * FF + col) = p;
    }
};


__device__ __forceinline__ void gate_finish(LAS unsigned char* lds, const f32x4 (&acc)[2][1], int rt, const float* rowss, const float* biasgr, const float* bgate, float* LOGF, int tid, int lane, int wave) {
    constexpr int PW = 2 * 1088;
    const int fr = lane & 15, fq = lane >> 4;
#pragma unroll
    for (int rb = 0; rb < 2; ++rb) *(LAS f32x4*)(lds + wave * PW + rb * 1088 + fq * 272 + fr * 16) = acc[rb][0];
    __syncthreads();
    {
        const int r = tid >> 4, q = tid & 15, m = 32 * rt + r;
        f32x4 v = (f32x4){0.f, 0.f, 0.f, 0.f};
        const int off = (r >> 4) * 1088 + (q & 3) * 272 + (r & 15) * 16;
#pragma unroll
        for (int w = 0; w < 8; ++w) v += *(const LAS f32x4*)(lds + w * PW + off);
        v = v * rsqrtf(rowss[m] * (1.f / DM) + EPS) + *(const f32x4*)(biasgr + (size_t)modrow(m) * 64 + 4 * (q & 3));
        float gr[16];
#pragma unroll
        for (int qq = 0; qq < 4; ++qq) { const int src = (lane & 48) + qq;
            gr[4 * qq + 0] = __shfl(v.x, src); gr[4 * qq + 1] = __shfl(v.y, src); gr[4 * qq + 2] = __shfl(v.z, src); gr[4 * qq + 3] = __shfl(v.w, src); }
        const LAS float* wgate = (const LAS float*)(lds + 65536);
        f32x4 pre[4];
#pragma unroll
        for (int i = 0; i < 4; ++i) pre[i] = *(const f32x4*)(bgate + 4 * q + 64 * i);
#pragma unroll
        for (int rr = 0; rr < 16; ++rr)
#pragma unroll
            for (int i = 0; i < 4; ++i) pre[i] += gr[rr] * *(const LAS f32x4*)(wgate + rr * 256 + 4 * q + 64 * i);
#pragma unroll
        for (int i = 0; i < 4; ++i) { f32x4 o;
#pragma unroll
            for (int jj = 0; jj < 4; ++jj) { const float pv = pre[i][jj]; o[jj] = (fminf(pv, 0.f) - __logf(1.f + __expf(-fabsf(pv)))) * (1.f / 16.f); }
            *(f32x4*)(LOGF + (size_t)m * 256 + 4 * q + 64 * i) = o; }
    }
    __syncthreads();
}
__device__ __forceinline__ void gate_gemm(LAS unsigned char* lds, const bf16* Hall, const bf16* WGR, const float* wg, const float* rowss, const float* biasgr, const float* bgate, float* LOGF,
                                          int tid, int lane, int wave, int bid, int G) {
    for (int idx = tid; idx < 1024; idx += 512) *(LAS f32x4*)(lds + 65536 + 16 * idx) = *(const f32x4*)(wg + 4 * idx);
    for (int rnd = 0; rnd < 2; ++rnd) {
        int it, it1; bool two;
        if (G == 256) {
            if (bid < 128) { if (rnd == 0) { it = bid; it1 = 512 + bid; two = bid < 8; } else break; }
            else { const int t0 = 128 + 3 * (bid - 128); if (rnd == 0) { it = t0; it1 = t0 + 1; two = true; } else { it = t0 + 2; it1 = it; two = false; } }
        } else { if (rnd == 1 || bid >= MT / 32) break; it = bid; it1 = bid; two = false; }
        f32x4 acc0[2][1], acc1[2][1];
        if (two) {
            sg_compute<16, DM, false>(acc0, Hall, WGR, it, 0, lane, wave);
            sg_compute<16, DM, false>(acc1, Hall, WGR, it1, 0, lane, wave);
            gate_finish(lds, acc0, it, rowss, biasgr, bgate, LOGF, tid, lane, wave);
            gate_finish(lds, acc1, it1, rowss, biasgr, bgate, LOGF, tid, lane, wave);
        } else {
            sg_compute<16, DM, false>(acc0, Hall, WGR, it, 0, lane, wave);
            gate_finish(lds, acc0, it, rowss, biasgr, bgate, LOGF, tid, lane, wave);
        }
    }
    if (G != 256) for (int it = bid + G; it < MT / 32; it += G) { f32x4 acc0[2][1]; sg_compute<16, DM, false>(acc0, Hall, WGR, it, 0, lane, wave); gate_finish(lds, acc0, it, rowss, biasgr, bgate, LOGF, tid, lane, wave); }
}
#define XB_TMO      128
#define XB_XCNT(j)  (256  + 64 * (j))
#define XB_XSUB(j)  (1280 + 64 * (j))
#define XB_XGEN(j)  (2304 + 64 * (j))
#define XB_TOP      3328
#define XB_TOPGEN   3392
#define XCD_BAR_WORDS 3456
#define XB_SPIN_CAP (1u << 18)

__device__ __forceinline__ unsigned xb_ld(unsigned* p)              { return __hip_atomic_load(p, __ATOMIC_RELAXED, __HIP_MEMORY_SCOPE_AGENT); }
__device__ __forceinline__ unsigned xb_add(unsigned* p, unsigned v) { return __hip_atomic_fetch_add(p, v, __ATOMIC_RELAXED, __HIP_MEMORY_SCOPE_AGENT); }
__device__ __forceinline__ unsigned xb_xcc_id() { return (unsigned)__builtin_amdgcn_s_getreg((3 << 11) | 20) & 0xFu; }
#define XB_SPIN(cond, bar) do { unsigned _sp = 0; while (cond) { __builtin_amdgcn_s_sleep(1); \
    if ((++_sp & 255u) == 0u) { if (xb_ld(&(bar)[XB_TMO])) break; if (_sp > XB_SPIN_CAP) { atomicAdd(&(bar)[XB_TMO], 1u); break; } } } } while (0)

struct XcdBarrier {
    unsigned* bar; unsigned x;
    volatile LAS unsigned* st;
};

__device__ __forceinline__ XcdBarrier xcd_barrier_post(unsigned* bar, volatile LAS unsigned* st) {
    XcdBarrier b; b.bar = bar; b.x = xb_xcc_id(); b.st = st;
    if (threadIdx.x == 0) (void)xb_add(&bar[XB_XCNT(b.x)], 1u);
    return b;
}
__device__ __forceinline__ void xcd_barrier_complete(unsigned* bar, unsigned x, unsigned& nloc, unsigned& nx) {
    const unsigned G = gridDim.x * gridDim.y * gridDim.z;
    unsigned sum, cnt, mine, sp = 0u;
    for (;;) {
        sum = 0u; cnt = 0u; mine = 0u;
#pragma unroll
        for (unsigned j = 0; j < 16; ++j) { const unsigned c = xb_ld(&bar[XB_XCNT(j)]); sum += c; cnt += (c > 0u) ? 1u : 0u; mine = (j == x) ? c : mine; }
        if (sum == G) break;
        __builtin_amdgcn_s_sleep(1);
        if ((++sp & 255u) == 0u) { if (xb_ld(&bar[XB_TMO])) break; if (sp > XB_SPIN_CAP) { atomicAdd(&bar[XB_TMO], 1u); break; } }
    }
    nloc = mine > 0u ? mine : 1u; nx = cnt > 0u ? cnt : 1u;
}

__device__ __forceinline__ void xcd_barrier(const XcdBarrier& b) {
    asm volatile("s_waitcnt vmcnt(0)" ::: "memory");
    __syncthreads();
    if (threadIdx.x == 0) {
        unsigned* bar = b.bar; unsigned bx_ = b.x; asm volatile("" : "+v"(bar), "+v"(bx_));
        __builtin_amdgcn_s_waitcnt(0);
        unsigned nloc = b.st[0], nx = b.st[1];
        if (nloc == 0u) { xcd_barrier_complete(bar, bx_, nloc, nx); b.st[0] = nloc; b.st[1] = nx; }
        const unsigned old = xb_add(&bar[XB_XSUB(bx_)], 1u);
        const unsigned gen = old / nloc;
        if (old + 1u == (gen + 1u) * nloc) {
            __builtin_amdgcn_fence(__ATOMIC_RELEASE, "agent");
            asm volatile("s_waitcnt vmcnt(0)" ::: "memory");
            const unsigned og = xb_add(&bar[XB_TOP], 1u);
            const unsigned tg = og / nx;
            if (og + 1u == (tg + 1u) * nx) xb_add(&bar[XB_TOPGEN], 1u);
            else XB_SPIN(xb_ld(&bar[XB_TOPGEN]) == tg, bar);
            __builtin_amdgcn_fence(__ATOMIC_ACQUIRE, "agent");
            xb_add(&bar[XB_XGEN(bx_)], 1u);
            asm volatile("s_waitcnt vmcnt(0)" ::: "memory");
        } else {
            XB_SPIN(xb_ld(&bar[XB_XGEN(bx_)]) == gen, bar);
            __builtin_amdgcn_fence(__ATOMIC_ACQUIRE, "agent");
            asm volatile("s_waitcnt vmcnt(0)" ::: "memory");
        }
    }
    __syncthreads();
}


__device__ __forceinline__ void attn_unit(LAS unsigned char* lds, const bf16* Qp, int nact, int qpos0, const float* kA, const float* vA, const float* kB, const float* vB,
                                          int split, int nkeys, bf16* Op, int tid, int lane, int wave) {
    const int fr = lane & 15, fq = lane >> 4;
    const bool wact0 = wave < nact;
    bf16x8 qf0 = {0, 0, 0, 0, 0, 0, 0, 0}, qf1 = qf0;
    if (wact0) { const bf16* qr = Qp + (size_t)(16 * wave + fr) * 512 + 8 * fq; qf0 = *(const bf16x8*)qr; qf1 = *(const bf16x8*)(qr + 32); }
    const int qpos = qpos0 + 16 * wave + fr, qmaxw = qpos0 + 16 * wave + 15;
    float R = 0.f;
    f32x4 o[4];
#pragma unroll
    for (int i = 0; i < 4; ++i) o[i] = (f32x4){0.f, 0.f, 0.f, 0.f};
    bool wact = wact0;
    unsigned tri0, tri1;
    { const unsigned b0 = (4 * fq + 0 >= fr) ? 0x3F80u : 0u, b1 = (4 * fq + 1 >= fr) ? 0x3F80u : 0u, b2 = (4 * fq + 2 >= fr) ? 0x3F80u : 0u, b3 = (4 * fq + 3 >= fr) ? 0x3F80u : 0u;
      tri0 = b0 | (b1 << 16); tri1 = b2 | (b3 << 16); }
    const unsigned ONE2 = 0x3F803F80u;
    const bf16x8 TA = __builtin_bit_cast(bf16x8, (u32x4){tri0, tri1, ONE2, ONE2});
    const bf16x8 TB = __builtin_bit_cast(bf16x8, (u32x4){ONE2, ONE2, ONE2, ONE2});
    const bf16x8 TC = __builtin_bit_cast(bf16x8, (u32x4){0u, 0u, tri0, tri1});
    volatile LAS int* flags = (volatile LAS int*)(lds + 36864);
    int cur = 0;
    const int key = tid >> 3, d0 = (tid & 7) * 8;
    int jt = (qpos0 + 16 * nact - 2) >> 6;
    f32x4 pk0, pk1, pv0, pv1;
#define ATT_LOAD(JT) do { const int kap_ = 64 * (JT) + key; \
        if (kap_ < nkeys) { const float* kp_ = (kap_ < split ? kA + (size_t)kap_ * 512 : kB + (size_t)(kap_ - split) * 512) + d0; \
                            const float* vp_ = (kap_ < split ? vA + (size_t)kap_ * 512 : vB + (size_t)(kap_ - split) * 512) + d0; \
                            pk0 = *(const f32x4*)kp_; pk1 = *(const f32x4*)(kp_ + 4); pv0 = *(const f32x4*)vp_; pv1 = *(const f32x4*)(vp_ + 4); } \
        else { pk0 = pk1 = pv0 = pv1 = (f32x4){0.f, 0.f, 0.f, 0.f}; } } while (0)
#define ATT_WRITE(BUF) do { LAS unsigned char* Kw_ = lds + (BUF) * 18432; \
          u32x4 kw; kw.x = pk2(pk0.x, pk0.y); kw.y = pk2(pk0.z, pk0.w); kw.z = pk2(pk1.x, pk1.y); kw.w = pk2(pk1.z, pk1.w); \
          *(LAS u32x4*)(Kw_ + key * 144 + d0 * 2) = kw; \
            \
          u32x4 vw; vw.x = pk2(pv0.x, pv0.y); vw.y = pk2(pv0.z, pv0.w); vw.z = pk2(pv1.x, pv1.y); vw.w = pk2(pv1.z, pv1.w); \
          *(LAS u32x4*)(Kw_ + 9216 + key * 144 + d0 * 2) = vw; } while (0)
    ATT_LOAD(jt);
    ATT_WRITE(0);
    __syncthreads();
    for (;;) {
        LAS unsigned char* Ks = lds + cur * 18432; LAS unsigned char* VT = Ks + 9216;
        if (jt > 0) ATT_LOAD(jt - 1);
        if (wact && 64 * jt < qmaxw) {
            f32x4 s[4];
#pragma unroll
            for (int n = 0; n < 4; ++n) {
                const LAS unsigned char* kp = Ks + (16 * n + fr) * 144 + 16 * fq;
                const bf16x8 ka = *(const LAS bf16x8*)kp, kb = *(const LAS bf16x8*)(kp + 64);
                s[n] = MFMA16(ka, qf0, ((f32x4){0.f, 0.f, 0.f, 0.f}));
                s[n] = MFMA16(kb, qf1, s[n]);
            }
            const int kbase = 64 * jt + 4 * fq;
            const bool full = 64 * jt + 64 <= qpos0 + 16 * wave;
            f32x4 l2[4];
#pragma unroll
            for (int n = 0; n < 4; ++n)
#pragma unroll
                for (int j = 0; j < 4; ++j) { const bool valid = full || (kbase + 16 * n + j) < qpos; const float e = __builtin_amdgcn_exp2f(s[n][j]); const float lg = -__builtin_amdgcn_logf(1.f + e); l2[n][j] = valid ? lg : 0.f; }
            const bf16x8 lb0 = pack8(l2[0], l2[1]), lb1 = pack8(l2[2], l2[3]);
            const f32x4 z4 = (f32x4){0.f, 0.f, 0.f, 0.f};
            f32x4 suf[4];
            suf[0] = MFMA16(TA, lb0, z4); suf[0] = MFMA16(TB, lb1, suf[0]);
            suf[1] = MFMA16(TC, lb0, z4); suf[1] = MFMA16(TB, lb1, suf[1]);
            suf[2] = MFMA16(TA, lb1, z4);
            suf[3] = MFMA16(TC, lb1, z4);
            const float tot = __shfl(suf[0][0], fr);
            f32x4 p[4];
#pragma unroll
            for (int n = 0; n < 4; ++n)
#pragma unroll
                for (int j = 0; j < 4; ++j) { const bool valid = full || (kbase + 16 * n + j) < qpos; const float w = __builtin_amdgcn_exp2f(s[n][j] + suf[n][j] + R); p[n][j] = valid ? w : 0.f; }
            R += tot;
            const bf16x8 pb0 = pack8(p[0], p[1]), pb1 = pack8(p[2], p[3]);
#pragma unroll
            for (int db = 0; db < 4; ++db) {
                const LAS unsigned char* vp = VT + (4 * fq + (fr >> 2)) * 144 + 32 * db + 8 * (fr & 3);
                typedef short v4i16_t __attribute__((ext_vector_type(4)));
                const v4i16_t t0 = __builtin_amdgcn_ds_read_tr16_b64_v4i16((LAS v4i16_t*)(vp)),             t1 = __builtin_amdgcn_ds_read_tr16_b64_v4i16((LAS v4i16_t*)(vp + 16 * 144)),
                              t2 = __builtin_amdgcn_ds_read_tr16_b64_v4i16((LAS v4i16_t*)(vp + 32 * 144)), t3 = __builtin_amdgcn_ds_read_tr16_b64_v4i16((LAS v4i16_t*)(vp + 48 * 144));
                const bf16x8 va0 = {t0[0], t0[1], t0[2], t0[3], t1[0], t1[1], t1[2], t1[3]}, va1 = {t2[0], t2[1], t2[2], t2[3], t3[0], t3[1], t3[2], t3[3]};
                o[db] = MFMA16(va0, pb0, o[db]); o[db] = MFMA16(va1, pb1, o[db]);
            }
            wact = __any(R > -150.f);
        }
        if (jt > 0) ATT_WRITE(cur ^ 1);
        if (lane == 0) flags[(jt & 1) * 8 + wave] = wact ? 1 : 0;
        __syncthreads();
        if (jt == 0) break;
        int any = 0;
#pragma unroll
        for (int w = 0; w < 8; ++w) any |= flags[(jt & 1) * 8 + w];
        if (!any) break;
        --jt; cur ^= 1;
    }
#undef ATT_LOAD
#undef ATT_WRITE
    if (wact0) {
        bf16* op = Op + (size_t)(16 * wave + fr) * 1024 + 4 * fq;
#pragma unroll
        for (int db = 0; db < 4; ++db) { u32x2 w; w.x = pk2(o[db].x, o[db].y); w.y = pk2(o[db].z, o[db].w); *(u32x2*)(op + 16 * db) = w; }
    }
    __syncthreads();
}

__device__ __forceinline__ void gla_a_unit(const Args& a, LAS unsigned char* lds, int b, int c, int hh, int tid, int lane, int wave) {
    const float* LOGF = (const float*)(a.ws + WS_LOGF); const bf16* KG = (const bf16*)(a.ws + WS_KG); const bf16* VG = (const bf16*)(a.ws + WS_VG);
    float* U = (float*)(a.ws + WS_U); float* ACH = (float*)(a.ws + WS_ACH);
    const int m0 = b * 8192 + 64 * c, unit = (b * 128 + c) * 4 + hh;
    LAS float* gsum = (LAS float*)lds;
    LAS unsigned char* kT = lds + 2048;
    LAS unsigned char* vT = lds + 11264;
    const int d = tid & 63, g = tid >> 6;
    float lf[8];
#pragma unroll
    for (int i = 0; i < 8; ++i) lf[i] = LOGF[(size_t)(m0 + 8 * g + i) * 256 + hh * 64 + d];
    unsigned short kraw[8];
#pragma unroll
    for (int i = 0; i < 8; ++i) kraw[i] = KG[(size_t)(m0 + 8 * g + i) * 256 + hh * 64 + d];
    float es[8]; float run = 0.f;
#pragma unroll
    for (int i = 7; i >= 0; --i) { es[i] = run; run += lf[i]; }
    gsum[g * 64 + d] = run;
    { const int s = tid >> 4, c8 = (tid & 15) * 8;
      const u32x4 r0 = *(const u32x4*)(VG + (size_t)(m0 + s) * 512 + hh * 128 + c8), r1 = *(const u32x4*)(VG + (size_t)(m0 + s + 32) * 512 + hh * 128 + c8);
      *(LAS u32x4*)(vT + s * 272 + c8 * 2) = r0; *(LAS u32x4*)(vT + (s + 32) * 272 + c8 * 2) = r1; }
    __syncthreads();
    float later = 0.f, total = 0.f;
#pragma unroll
    for (int gg = 0; gg < 8; ++gg) { const float t = gsum[gg * 64 + d]; total += t; later += (gg > g) ? t : 0.f; }
    if (g == 0) ACH[(size_t)unit * 64 + d] = __expf(total);
    { float kk[8];
#pragma unroll
      for (int i = 0; i < 8; ++i) kk[i] = bf2f(kraw[i]) * __expf(es[i] + later);
      u32x4 w; w.x = pk2(kk[0], kk[1]); w.y = pk2(kk[2], kk[3]); w.z = pk2(kk[4], kk[5]); w.w = pk2(kk[6], kk[7]);
      *(LAS u32x4*)(kT + d * 144 + g * 16) = w; }
    __syncthreads();
    const int fr = lane & 15, fq = lane >> 4;
    typedef short v4i16_t __attribute__((ext_vector_type(4)));
    bf16x8 va0, va1;
    { const LAS unsigned char* vp = vT + (8 * fq + (fr >> 2)) * 272 + (16 * wave + 4 * (fr & 3)) * 2;
      const v4i16_t t0 = __builtin_amdgcn_ds_read_tr16_b64_v4i16((LAS v4i16_t*)(vp)), t1 = __builtin_amdgcn_ds_read_tr16_b64_v4i16((LAS v4i16_t*)(vp + 4 * 272)),
                    t2 = __builtin_amdgcn_ds_read_tr16_b64_v4i16((LAS v4i16_t*)(vp + 32 * 272)), t3 = __builtin_amdgcn_ds_read_tr16_b64_v4i16((LAS v4i16_t*)(vp + 36 * 272));
      va0 = (bf16x8){t0[0], t0[1], t0[2], t0[3], t1[0], t1[1], t1[2], t1[3]}; va1 = (bf16x8){t2[0], t2[1], t2[2], t2[3], t3[0], t3[1], t3[2], t3[3]}; }
    float* up = U + (size_t)unit * 8192 + (size_t)(16 * wave + 4 * fq) * 64 + fr;
#pragma unroll
    for (int db = 0; db < 4; ++db) {
        const bf16x8 kb0 = *(const LAS bf16x8*)(kT + (16 * db + fr) * 144 + 16 * fq), kb1 = *(const LAS bf16x8*)(kT + (16 * db + fr) * 144 + 64 + 16 * fq);
        f32x4 acc = MFMA16(va0, kb0, ((f32x4){0.f, 0.f, 0.f, 0.f})); acc = MFMA16(va1, kb1, acc);
        up[16 * db] = acc.x; up[16 * db + 64] = acc.y; up[16 * db + 128] = acc.z; up[16 * db + 192] = acc.w;
    }
    __syncthreads();
}

__device__ __forceinline__ void gla_scan(const Args& a, LAS unsigned char* lds, int l, int tid, int lane, int wave, int bid, int G) {
    const float* __restrict__ U = (const float*)(a.ws + WS_U); bf16* __restrict__ S = (bf16*)(a.ws + WS_S); const float* __restrict__ ACH = (const float*)(a.ws + WS_ACH);
    float* __restrict__ outp = a.out;
    LAS f32x4* cP = (LAS f32x4*)lds;
    LAS f32x4* cS = (LAS f32x4*)(lds + 8192);
    for (int it = bid; it < 256; it += G) {
        const int bh = it >> 5, b = bh >> 2, hh = bh & 3, e = (it & 31) * 256 + 4 * lane, d = e & 63, v = e >> 6;
        f32x4 u[16], p[16];
#pragma unroll
        for (int i = 0; i < 16; ++i) { const size_t unit = (size_t)(b * 128 + 16 * wave + i) * 4 + hh; u[i] = *(const f32x4*)(U + unit * 8192 + e); p[i] = *(const f32x4*)(ACH + unit * 64 + d); }
        f32x4 s = (f32x4){0.f, 0.f, 0.f, 0.f}, pr = (f32x4){1.f, 1.f, 1.f, 1.f};
#pragma unroll
        for (int i = 0; i < 16; ++i) { s = p[i] * s + u[i]; pr = pr * p[i]; u[i] = s; p[i] = pr; }
        cP[wave * 64 + lane] = pr; cS[wave * 64 + lane] = s;
        __syncthreads();
        f32x4 carry = (f32x4){0.f, 0.f, 0.f, 0.f};
        for (int w = 0; w < wave; ++w) carry = cP[w * 64 + lane] * carry + cS[w * 64 + lane];
#pragma unroll
        for (int i = 0; i < 16; ++i) { const size_t unit = (size_t)(b * 128 + 16 * wave + i) * 4 + hh; u[i] = u[i] + p[i] * carry; u32x2 sb; sb.x = pk2(u[i].x, u[i].y); sb.y = pk2(u[i].z, u[i].w); *(u32x2*)(S + unit * 8192 + e) = sb; }
        if (wave == 7) { float* op = outp + OUT_SP + ((size_t)(l * 2 + b) * 4 + hh) * 8192 + v;
            op[(d + 0) * 128] = u[15].x; op[(d + 1) * 128] = u[15].y; op[(d + 2) * 128] = u[15].z; op[(d + 3) * 128] = u[15].w; }
        __syncthreads();
    }
}

__device__ __forceinline__ void gla_c_unit(const Args& a, LAS unsigned char* lds, int l, int b, int c, int hh, int tid, int lane, int wave) {
    const float* LOGF = (const float*)(a.ws + WS_LOGF); const bf16* QG = (const bf16*)(a.ws + WS_QG); const bf16* KG = (const bf16*)(a.ws + WS_KG);
    const bf16* VG = (const bf16*)(a.ws + WS_VG); const bf16* OG = (const bf16*)(a.ws + WS_OG); const bf16* U = (const bf16*)(a.ws + WS_S);
    bf16* MERGED = (bf16*)(a.ws + WS_MERGED); const float* gn = a.in[16] + l * 128;
    const int m0 = b * 8192 + 64 * c, unit = (b * 128 + c) * 4 + hh;
    LAS float* gsum = (LAS float*)lds;
    LAS float* Btab = (LAS float*)(lds + 2048);
    LAS unsigned char* Qs = lds + 18432;
    LAS unsigned char* Ks = lds + 27648;
    LAS unsigned char* vT = lds + 36864;
    LAS float* part = (LAS float*)(lds + 55296);
    const int fr = lane & 15, fq = lane >> 4;
    const int tb = wave & 3, vh = wave >> 2;
    const int d_ = tid & 63, g_ = tid >> 6;
    float lf[8];
#pragma unroll
    for (int i = 0; i < 8; ++i) lf[i] = LOGF[(size_t)(m0 + 8 * g_ + i) * 256 + hh * 64 + d_];
    const int vs_ = tid >> 4, vc8_ = (tid & 15) * 8;
    const u32x4 vr0 = *(const u32x4*)(VG + (size_t)(m0 + vs_) * 512 + hh * 128 + vc8_), vr1 = *(const u32x4*)(VG + (size_t)(m0 + vs_ + 32) * 512 + hh * 128 + vc8_);
    const int t_ = tid >> 3, d0_ = (tid & 7) * 8;
    const u32x4 qw = *(const u32x4*)(QG + (size_t)(m0 + t_) * 256 + hh * 64 + d0_), kw = *(const u32x4*)(KG + (size_t)(m0 + t_) * 256 + hh * 64 + d0_);
    bf16x8 sfr[4][2];
    if (c > 0) {
#pragma unroll
        for (int i = 0; i < 4; ++i) { const bf16* sp = U + (size_t)(unit - 4) * 8192 + (size_t)(16 * (4 * vh + i) + fr) * 64 + 8 * fq;
            sfr[i][0] = *(const bf16x8*)sp; sfr[i][1] = *(const bf16x8*)(sp + 32); }
    }
    const int m = m0 + 16 * tb + fr;
    u32x2 ogw[4]; f32x4 gnv[4];
#pragma unroll
    for (int i = 0; i < 4; ++i) { const int v0 = 16 * (4 * vh + i) + 4 * fq; ogw[i] = *(const u32x2*)(OG + (size_t)m * 512 + hh * 128 + v0); gnv[i] = *(const f32x4*)(gn + v0); }
    { float run = 0.f;
#pragma unroll
      for (int i = 0; i < 8; ++i) { run += lf[i]; lf[i] = run; }
      gsum[g_ * 64 + d_] = run;
      *(LAS u32x4*)(vT + vs_ * 272 + vc8_ * 2) = vr0; *(LAS u32x4*)(vT + (vs_ + 32) * 272 + vc8_ * 2) = vr1;
      __syncthreads();
      float earlier = 0.f;
#pragma unroll
      for (int gg = 0; gg < 8; ++gg) earlier += (gg < g_) ? gsum[gg * 64 + d_] : 0.f;
#pragma unroll
      for (int i = 0; i < 8; ++i) Btab[(8 * g_ + i) * 64 + d_] = lf[i] + earlier;
    }
    __syncthreads();
    { const int t = t_, d0 = d0_;
      const f32x4 b0 = *(const LAS f32x4*)(Btab + t * 64 + d0), b1 = *(const LAS f32x4*)(Btab + t * 64 + d0 + 4);
      float eb[8] = {__expf(b0.x), __expf(b0.y), __expf(b0.z), __expf(b0.w), __expf(b1.x), __expf(b1.y), __expf(b1.z), __expf(b1.w)};
      float ib[8] = {__expf(-b0.x), __expf(-b0.y), __expf(-b0.z), __expf(-b0.w), __expf(-b1.x), __expf(-b1.y), __expf(-b1.z), __expf(-b1.w)};
      u32x4 qo, ko;
      qo.x = pk2(bflo(qw.x) * eb[0], bfhi(qw.x) * eb[1]); qo.y = pk2(bflo(qw.y) * eb[2], bfhi(qw.y) * eb[3]); qo.z = pk2(bflo(qw.z) * eb[4], bfhi(qw.z) * eb[5]); qo.w = pk2(bflo(qw.w) * eb[6], bfhi(qw.w) * eb[7]);
      ko.x = pk2(bflo(kw.x) * ib[0], bfhi(kw.x) * ib[1]); ko.y = pk2(bflo(kw.y) * ib[2], bfhi(kw.y) * ib[3]); ko.z = pk2(bflo(kw.z) * ib[4], bfhi(kw.z) * ib[5]); ko.w = pk2(bflo(kw.w) * ib[6], bfhi(kw.w) * ib[7]);
      *(LAS u32x4*)(Qs + t * 144 + d0 * 2) = qo; *(LAS u32x4*)(Ks + t * 144 + d0 * 2) = ko; }
    __syncthreads();
    const bf16x8 qb0 = *(const LAS bf16x8*)(Qs + (16 * tb + fr) * 144 + 16 * fq), qb1 = *(const LAS bf16x8*)(Qs + (16 * tb + fr) * 144 + 64 + 16 * fq);
    const f32x4 z4 = (f32x4){0.f, 0.f, 0.f, 0.f};
    f32x4 at[4];
#pragma unroll
    for (int sb = 0; sb < 4; ++sb) {
        at[sb] = z4;
        if (sb <= tb) {
            const bf16x8 k0 = *(const LAS bf16x8*)(Ks + (16 * sb + fr) * 144 + 16 * fq), k1 = *(const LAS bf16x8*)(Ks + (16 * sb + fr) * 144 + 64 + 16 * fq);
            f32x4 t = MFMA16(k0, qb0, z4); t = MFMA16(k1, qb1, t);
            if (sb == tb) {
#pragma unroll
                for (int j = 0; j < 4; ++j) t[j] = (4 * fq + j <= fr) ? t[j] : 0.f;
            }
            at[sb] = t;
        }
    }
    const bf16x8 ab0 = pack8(at[0], at[1]), ab1 = pack8(at[2], at[3]);
    f32x4 o[4];
#pragma unroll
    for (int i = 0; i < 4; ++i) {
        const int vb = 4 * vh + i;
        typedef short v4i16_t __attribute__((ext_vector_type(4)));
        const LAS unsigned char* vp = vT + (4 * fq + (fr >> 2)) * 272 + (16 * vb + 4 * (fr & 3)) * 2;
        const v4i16_t t0 = __builtin_amdgcn_ds_read_tr16_b64_v4i16((LAS v4i16_t*)(vp)), t1 = __builtin_amdgcn_ds_read_tr16_b64_v4i16((LAS v4i16_t*)(vp + 16 * 272));
        f32x4 acc = MFMA16(((bf16x8){t0[0], t0[1], t0[2], t0[3], t1[0], t1[1], t1[2], t1[3]}), ab0, z4);
        if (tb >= 2) { const v4i16_t t2 = __builtin_amdgcn_ds_read_tr16_b64_v4i16((LAS v4i16_t*)(vp + 32 * 272)), t3 = __builtin_amdgcn_ds_read_tr16_b64_v4i16((LAS v4i16_t*)(vp + 48 * 272));
                       acc = MFMA16(((bf16x8){t2[0], t2[1], t2[2], t2[3], t3[0], t3[1], t3[2], t3[3]}), ab1, acc); }
        if (c > 0) { acc = MFMA16(sfr[i][0], qb0, acc); acc = MFMA16(sfr[i][1], qb1, acc); }
        o[i] = acc;
    }
    float ss = 0.f;
#pragma unroll
    for (int i = 0; i < 4; ++i) ss += (o[i].x * o[i].x + o[i].y * o[i].y) + (o[i].z * o[i].z + o[i].w * o[i].w);
    ss += __shfl_xor(ss, 16); ss += __shfl_xor(ss, 32);
    if (fq == 0) part[wave * 16 + fr] = ss;
    __syncthreads();
    const float tot = part[wave * 16 + fr] + part[(wave ^ 4) * 16 + fr];
    const float rstd = rsqrtf(tot * (1.f / 128.f) + EPS);
#pragma unroll
    for (int i = 0; i < 4; ++i) {
        const int v0 = 16 * (4 * vh + i) + 4 * fq;
        const f32x4 g = gnv[i];
        const float r0 = o[i].x * rstd * g.x * silu_f(bflo(ogw[i].x)), r1 = o[i].y * rstd * g.y * silu_f(bfhi(ogw[i].x));
        const float r2 = o[i].z * rstd * g.z * silu_f(bflo(ogw[i].y)), r3 = o[i].w * rstd * g.w * silu_f(bfhi(ogw[i].y));
        u32x2 w; w.x = pk2(r0, r1); w.y = pk2(r2, r3);
        *(u32x2*)(MERGED + (size_t)m * 1024 + 512 + hh * 128 + v0) = w;
    }
    __syncthreads();
}

__device__ __forceinline__ void gla_sample_unit(const Args& a, LAS unsigned char* lds, int l, int b, int hh, int part, int tid) {
    const float* LOGF = (const float*)(a.ws + WS_LOGF); const bf16* QG = (const bf16*)(a.ws + WS_QG); const bf16* KG = (const bf16*)(a.ws + WS_KG);
    const bf16* VG = (const bf16*)(a.ws + WS_VG); const bf16* OG = (const bf16*)(a.ws + WS_OG);
    bf16* MERGED = (bf16*)(a.ws + WS_MERGED); const float* gn = a.in[16] + l * 128;
    const float* S0g = a.in[6] + ((size_t)(l * 16 + b) * 4 + hh) * 8192;
    float* Sout = a.out + OUT_SS + ((size_t)(l * 16 + b) * 4 + hh) * 8192;
    const int m0 = TP + 16 * b;
    LAS float* S0 = (LAS float*)lds;
    LAS float* qp = (LAS float*)(lds + 32768);
    LAS float* kpp = qp + 1024;
    LAS float* kl = kpp + 1024;
    LAS float* vv = kl + 1024;
    LAS float* att = vv + 2048;
    LAS float* exl = att + 64;
    LAS float* pss = exl + 64;
#pragma unroll 4
    for (int i = tid; i < 2048; i += 512) *(LAS f32x4*)(S0 + 4 * i) = *(const f32x4*)(S0g + 4 * i);
#pragma unroll 2
    for (int i = tid; i < 2048; i += 512) { const int t = i >> 7, v = i & 127; vv[i] = bf2f(VG[(size_t)(m0 + t) * 512 + hh * 128 + v]); }
    if (tid < 64) {
        const int d = tid; float bb[16]; float run = 0.f;
#pragma unroll
        for (int t = 0; t < 16; ++t) { run += LOGF[(size_t)(m0 + t) * 256 + hh * 64 + d]; bb[t] = run; }
        exl[d] = __expf(run);
#pragma unroll
        for (int t = 0; t < 16; ++t) {
            const float q = bf2f(QG[(size_t)(m0 + t) * 256 + hh * 64 + d]), k = bf2f(KG[(size_t)(m0 + t) * 256 + hh * 64 + d]);
            qp[t * 64 + d] = q * __expf(bb[t]); kpp[t * 64 + d] = k * __expf(-bb[t]); kl[t * 64 + d] = k * __expf(run - bb[t]);
        }
    }
    __syncthreads();
    if (tid < 64) { const int t = 4 * part + (tid >> 4), s = tid & 15; float acc = 0.f;
        if (s <= t) {
#pragma unroll 4
            for (int d = 0; d < 64; ++d) acc += qp[t * 64 + d] * kpp[s * 64 + d]; }
        att[tid] = acc; }
    __syncthreads();
    const int v = tid & 127, ti = tid >> 7, t = 4 * part + ti;
    float o1 = 0.f;
#pragma unroll 4
    for (int s = 0; s < 16; ++s) o1 += att[ti * 16 + s] * vv[s * 128 + v];
#pragma unroll 4
    for (int d = 0; d < 64; ++d) o1 += qp[t * 64 + d] * S0[d * 128 + v];
    { const float sq = wave_sum(o1 * o1); if ((tid & 63) == 0) pss[ti * 2 + ((tid >> 6) & 1)] = sq; }
#pragma unroll
    for (int i = 0; i < 4; ++i) { const int d = 16 * part + 4 * ti + i; float acc = exl[d] * S0[d * 128 + v];
#pragma unroll 4
        for (int s = 0; s < 16; ++s) acc += kl[s * 64 + d] * vv[s * 128 + v];
        Sout[d * 128 + v] = acc; }
    __syncthreads();
    { const float tot = pss[ti * 2] + pss[ti * 2 + 1];
      const float rstd = rsqrtf(tot * (1.f / 128.f) + EPS);
      const float og = bf2f(OG[(size_t)(m0 + t) * 512 + hh * 128 + v]);
      MERGED[(size_t)(m0 + t) * 1024 + 512 + hh * 128 + v] = (bf16)f2bf(o1 * rstd * gn[v] * silu_f(og)); }
    __syncthreads();
}

#ifndef REP_PRO
#define REP_PRO 1
#endif
#ifndef REP_NORM0
#define REP_NORM0 1
#endif
#ifndef REP_NORM1
#define REP_NORM1 1
#endif
#ifndef REP_MIX
#define REP_MIX 1
#endif
#ifndef REP_GLAS
#define REP_GLAS 1
#endif
#ifndef REP_GLAC
#define REP_GLAC 1
#endif
#ifndef REP_GIN
#define REP_GIN 1
#endif
#ifndef REP_GUP
#define REP_GUP 1
#endif
#ifndef USE_QUEUE
#define USE_QUEUE 1
#endif
#ifndef REP_GOUT
#define REP_GOUT 1
#endif
#ifndef REP_GDN
#define REP_GDN 1
#endif
#ifndef REP_SCAN
#define REP_SCAN 1
#endif
#ifndef REP_SG
#define REP_SG 1
#endif
__global__ void __launch_bounds__(512) mk_fwd(Args a) {
    extern __shared__ __attribute__((aligned(16))) unsigned char lds_raw[];
    LAS unsigned char* lds = (LAS unsigned char*)lds_raw;
    cg::grid_group grid = cg::this_grid();
    const int G = gridDim.x, bid = blockIdx.x;
#ifndef REP_BAR
#define REP_BAR 1
#endif
#define GRID_BAR() do { for (int rb_ = 0; rb_ < REP_BAR; ++rb_) xcd_barrier(bar); } while (0)
#define FRESH() int tid, lane, wave; { int t_ = threadIdx.x; asm volatile("" : "+v"(t_)); tid = t_; lane = t_ & 63; wave = __builtin_amdgcn_readfirstlane(t_ >> 6); }
#define FRESH_WS() unsigned char* ws_ = a.ws; asm volatile("" : "+s"(ws_))
#define LDP(i) ((const float*)ld_ptr(lds + ARGS_OFF + 8 * (i)))
#define FRESH_ARGS() Args a; { a.in[0] = LDP(0); a.in[1] = LDP(1); a.in[2] = LDP(2); a.in[3] = LDP(3); a.in[4] = LDP(4); a.in[5] = LDP(5); a.in[6] = LDP(6); a.in[7] = LDP(7); a.in[8] = LDP(8); a.in[9] = LDP(9); \
    a.in[10] = LDP(10); a.in[11] = LDP(11); a.in[12] = LDP(12); a.in[13] = LDP(13); a.in[14] = LDP(14); a.in[15] = LDP(15); a.in[16] = LDP(16); a.in[17] = LDP(17); a.in[18] = LDP(18); a.in[19] = LDP(19); \
    a.out = (float*)LDP(20); a.ws = (unsigned char*)LDP(21); a.never = 0; a.pad = 0; }
#define WIN ((bf16*)(a.ws + WS_WIN))
#define WOUT ((bf16*)(a.ws + WS_WOUT))
#define WUP ((bf16*)(a.ws + WS_WUP))
#define WDN ((bf16*)(a.ws + WS_WDN))
#define H ((bf16*)(a.ws + WS_H))
#define Q ((bf16*)(a.ws + WS_Q))
#define MERGED ((bf16*)(a.ws + WS_MERGED))
#define UU ((bf16*)(a.ws + WS_UU))
#define mod ((const float*)(a.ws + WS_MOD))
#define X (a.out)
#define XP (l == 0 ? a.in[0] : X)
#define XS (l == 0 ? a.in[1] : X + (size_t)TP * DM)
    for (int u = threadIdx.x; u < (LDS_BYTES - 131072) / 4; u += 512) ((LAS unsigned*)(lds + 131072))[u] = 0u;
    __syncthreads();
    XcdBarrier bar = xcd_barrier_post((unsigned*)(a.ws + WS_CTL) + 4096, (volatile LAS unsigned*)(lds + 131072 + 320 + 32));

#ifndef NO_PRO
    for (int rep_ = 0; rep_ < REP_PRO; ++rep_, __syncthreads()) { FRESH(); phase_prologue(a, lds, tid, lane, wave, G, bid); }
#endif
    if (a.never) grid.sync();
    GRID_BAR();
    for (int l = 0; l < 2; ++l) {
        if (l == 0) { { FRESH(); prep_phase(a, lds, tid, lane, wave, G, bid); } GRID_BAR(); }
        {
            pg8::Gemm g{H, WIN + (size_t)l * NING * DM, TP, NING, DM}; pg8::StaticOrder S; S.init(TP, NING, G, bid);
            EpiIn E{l, a.out, Q, (bf16*)(a.ws + WS_QG), (bf16*)(a.ws + WS_KG), (bf16*)(a.ws + WS_VG), (bf16*)(a.ws + WS_OG), a.in[12] + l * 64, a.in[13] + l * 64,
                    (const float*)(a.ws + WS_ROWSS_IN) + (size_t)l * MT, (const float*)(a.ws + WS_BIASIN) + (size_t)l * NROWS * NING};
            { SIn SE{l, a.out, Q, (bf16*)(a.ws + WS_QG), (bf16*)(a.ws + WS_KG), (bf16*)(a.ws + WS_VG), (bf16*)(a.ws + WS_OG), a.in[12] + l * 64, a.in[13] + l * 64,
                     (const float*)(a.ws + WS_ROWSS_IN) + (size_t)l * MT, (const float*)(a.ws + WS_BIASIN) + (size_t)l * NROWS * NING};
              for (int step = 0; step < 2; ++step) {
                  if ((step == 0) == ((bid & 1) == 0)) {
                      { FRESH(); gate_gemm(lds, H, (const bf16*)(a.ws + WS_WGR) + (size_t)l * 32 * DM, a.in[14] + l * 16 * 256, (const float*)(a.ws + WS_ROWSS_IN) + (size_t)l * MT,
                                           (const float*)(a.ws + WS_BIASGR) + (size_t)l * NROWS * 64, a.in[15] + l * 256, (float*)(a.ws + WS_LOGF), tid, lane, wave, bid, G); }
                      { FRESH(); small_gemm<64, DM, true, SIn>(lds, H + (size_t)TP * DM, WIN + (size_t)l * NING * DM, 8 * 48, SE, tid, lane, wave, bid, G); }
                  } else { pg8::gemm_phase<EpiIn, pg8::StaticOrder, true, true>(lds, g, S, E); __syncthreads(); }
              } }
        }
        GRID_BAR();
#ifndef NO_MIX
        {
            const int nq = (G % 8 == 0) ? 8 : 1, per = 2432 / nq;
            volatile LAS int* qslot = (volatile LAS int*)(lds + 131072 + 512);
            for (int hop = 0; hop < nq; ++hop) {
                const int x = (bid + hop) % nq;
                unsigned* qctr; { FRESH_WS(); qctr = (unsigned*)(ws_ + WS_CTL) + 64 * (16 + 8 * l + x); }
                int nxt = 0;
                if (threadIdx.x == 0) nxt = (int)atomicAdd(qctr, 1u);
                for (;;) {
                    if (threadIdx.x == 0) *qslot = nxt;
                    __syncthreads();
                    const int j = *qslot;
                    __syncthreads();
                    if (j >= per) break;
                    if (threadIdx.x == 0) nxt = (int)atomicAdd(qctr, 1u);
                    FRESH();
                    const int nA = 1024 / nq, nS = 128 / nq, nG = 256 / nq;
                    if (j < nA) { const int r = nA * x + j, bh = (r / nA) * (16 / nq) + (j % (16 / nq)), qb = 63 - (j / (16 / nq)), b = bh >> 3, hh = bh & 7;
                        const float* kA = a.out + OUT_KP + ((size_t)(l * 2 + b) * 8192) * 512 + hh * 64; const float* vA = a.out + OUT_VP + ((size_t)(l * 2 + b) * 8192) * 512 + hh * 64;
                        attn_unit(lds, Q + (size_t)(b * 8192 + 128 * qb) * 512 + hh * 64, 8, 128 * qb, kA, vA, kA, vA, 8192, 8192, MERGED + (size_t)(b * 8192 + 128 * qb) * 1024 + hh * 64, tid, lane, wave);
                    } else if (j < nA + nS) { const int r = nS * x + (j - nA), b = r >> 3, hh = r & 7;
                        const float* kA = a.in[4] + ((size_t)(l * 16 + b) * 1024) * 512 + hh * 64; const float* vA = a.in[5] + ((size_t)(l * 16 + b) * 1024) * 512 + hh * 64;
                        const float* kB = a.out + OUT_KS + ((size_t)(l * 16 + b) * 16) * 512 + hh * 64; const float* vB = a.out + OUT_VS + ((size_t)(l * 16 + b) * 16) * 512 + hh * 64;
                        attn_unit(lds, Q + (size_t)(TP + 16 * b) * 512 + hh * 64, 1, 1024, kA, vA, kB, vB, 1024, 1040, MERGED + (size_t)(TP + 16 * b) * 1024 + hh * 64, tid, lane, wave);
                    } else if (j < nA + nS + nG) { const int r = nG * x + (j - nA - nS);
                        gla_sample_unit(a, lds, l, r >> 4, (r >> 2) & 3, r & 3, tid);
                    } else { const int r = (1024 / nq) * x + (j - nA - nS - nG), hh = r & 3, c = (r >> 2) & 127, b = r >> 9;
                        gla_a_unit(a, lds, b, c, hh, tid, lane, wave);
                    }
                }
            }
        }
#endif
        GRID_BAR();
#ifndef NO_SCAN
        for (int rep_ = 0; rep_ < REP_SCAN; ++rep_, __syncthreads()) { FRESH(); gla_scan(a, lds, l, tid, lane, wave, bid, G); }
#endif
        GRID_BAR();
#ifndef NO_GLAC
        for (int rep_ = 0; rep_ < REP_GLAC; ++rep_, __syncthreads()) for (int it = bid; it < 1024; it += G) { FRESH(); const int hh = it & 3, c = (it >> 2) & 127, b = it >> 9; gla_c_unit(a, lds, l, b, c, hh, tid, lane, wave); }
#endif
        GRID_BAR();
        {
            pg8::Gemm g{MERGED, WOUT + (size_t)l * DM * DM, TP, DM, DM}; pg8::StaticOrder S; S.init(TP, DM, G, bid);
            EpiResN E{XP, X, mod + (size_t)l * NROWS * NMOD + 2 * DM, a.in[10] + l * DM, mod + (size_t)l * NROWS * NMOD + 4 * DM, H, (float*)(a.ws + WS_ROWSS) + (size_t)l * MT};
            { SResN SE{XS, X, mod + (size_t)l * NROWS * NMOD + 2 * DM, a.in[10] + l * DM, mod + (size_t)l * NROWS * NMOD + 4 * DM, H, (float*)(a.ws + WS_ROWSS) + (size_t)l * MT};
              for (int step = 0; step < 2; ++step) {
                  if ((step == 0) == ((bid & 1) == 0)) { FRESH(); small_gemm<32, DM, false, SResN>(lds, MERGED + (size_t)TP * DM, WOUT + (size_t)l * DM * DM, 8 * 32, SE, tid, lane, wave, bid, G); }
                  else { pg8::gemm_phase<EpiResN, pg8::StaticOrder, true, true>(lds, g, S, E); __syncthreads(); }
              } }
        }
        GRID_BAR();
        {
            pg8::Gemm g{H, WUP + (size_t)l * FF * DM, TP, FF, DM}; pg8::StaticOrder S; S.init(TP, FF, G, bid);
            EpiUpN E{UU, (const float*)(a.ws + WS_ROWSS) + (size_t)l * MT, (const float*)(a.ws + WS_BIASUP) + (size_t)l * NROWS * FF};
            { SUpN SE{UU, (const float*)(a.ws + WS_ROWSS) + (size_t)l * MT, (const float*)(a.ws + WS_BIASUP) + (size_t)l * NROWS * FF};
              for (int step = 0; step < 2; ++step) {
                  if ((step == 0) == ((bid & 1) == 0)) { FRESH(); small_gemm<64, DM, false, SUpN>(lds, H + (size_t)TP * DM, WUP + (size_t)l * FF * DM, 8 * 64, SE, tid, lane, wave, bid, G); }
                  else { pg8::gemm_phase<EpiUpN, pg8::StaticOrder, true, true>(lds, g, S, E); __syncthreads(); }
              } }
        }
        GRID_BAR();
        {
            pg8::Gemm g{UU, WDN + (size_t)l * DM * FF, TP, DM, FF}; pg8::StaticOrder S; S.init(TP, DM, G, bid);
            const int ln = l == 0 ? 1 : 0;
            EpiResN E{X, X, mod + (size_t)l * NROWS * NMOD + 5 * DM, a.in[9] + ln * DM, mod + (size_t)ln * NROWS * NMOD + 1 * DM, l == 0 ? H : (bf16*)nullptr, (float*)(a.ws + WS_ROWSS_IN) + (size_t)ln * MT};
            { const int ln = l == 0 ? 1 : 0;
              SResN SE{X + (size_t)TP * DM, X, mod + (size_t)l * NROWS * NMOD + 5 * DM, a.in[9] + ln * DM, mod + (size_t)ln * NROWS * NMOD + 1 * DM, l == 0 ? H : (bf16*)nullptr, (float*)(a.ws + WS_ROWSS_IN) + (size_t)ln * MT};
              for (int step = 0; step < 2; ++step) {
                  if ((step == 0) == ((bid & 1) == 0)) { FRESH(); small_gemm<32, FF, false, SResN>(lds, UU + (size_t)TP * FF, WDN + (size_t)l * DM * FF, 8 * 32, SE, tid, lane, wave, bid, G); }
                  else { pg8::gemm_phase<EpiResN, pg8::StaticOrder, true, true>(lds, g, S, E); __syncthreads(); }
              } }
        }
        if (l == 0) GRID_BAR();
    }
}

extern "C" void kernel_launch(void* const* d_in, const int* in_sizes, int n_in, void* d_out, int out_size, void* d_ws, size_t ws_size, hipStream_t stream) {
    static int grid = 0;
    if (grid == 0) {
        if (n_in != 20 || ws_size < WS_END) { fprintf(stderr, "kernel_launch: unexpected n_in %d / ws_size %zu (need %zu)\n", n_in, ws_size, (size_t)WS_END); grid = -1; return; }
        int dev = 0, cus = 0, per_cu = 0;
        (void)hipGetDevice(&dev); (void)hipDeviceGetAttribute(&cus, hipDeviceAttributeMultiprocessorCount, dev);
        if (hipFuncSetAttribute((const void*)mk_fwd, hipFuncAttributeMaxDynamicSharedMemorySize, LDS_BYTES) != hipSuccess) { fprintf(stderr, "kernel_launch: hipFuncSetAttribute failed\n"); grid = -1; return; }
        if (hipOccupancyMaxActiveBlocksPerMultiprocessor(&per_cu, (const void*)mk_fwd, 512, LDS_BYTES) != hipSuccess || per_cu < 1) { fprintf(stderr, "kernel_launch: occupancy query says %d\n", per_cu); per_cu = 1; }
        (void)hipGetLastError();
        grid = cus * 1;
        if (grid <= 0) grid = 256;
    }
    if (grid < 0) return;
    if (hipMemsetAsync((char*)d_ws + WS_CTL, 0, CTL_ZERO_BYTES, stream) != hipSuccess) { fprintf(stderr, "kernel_launch: memset failed\n"); return; }
    Args a{};
    for (int i = 0; i < 20; ++i) a.in[i] = (const float*)d_in[i];
    a.out = (float*)d_out; a.ws = (unsigned char*)d_ws; a.never = 0; a.pad = 0;
    void* args[] = {&a};
    hipError_t e = hipLaunchCooperativeKernel((const void*)mk_fwd, dim3(grid), dim3(512), args, LDS_BYTES, stream);
    if (e != hipSuccess) fprintf(stderr, "kernel_launch: cooperative launch failed: %s (grid %d)\n", hipGetErrorString(e), grid);
}
```
